# Optimizing an MI355X kernel written in HIP

```python
import math
import jax, jax.numpy as jnp
from jax import lax
import numpy as np

D_MODEL = 1024
BATCH = 2
SEQ = 8192
DEPTH = 1

GRID_W = 64
CTX_LEN = 256
S5_WIDTH = 512
S5_GROUP = 16
S5_GROUPS = S5_WIDTH // S5_GROUP
S5_STATE = 64
DT_MIN = 1e-3
DT_MAX = 1e-1
RET_WIDTH = D_MODEL - S5_WIDTH
RET_HEADS = 4
RET_HEAD_DIM = RET_WIDTH // RET_HEADS
RET_CHUNK = 128
ROPE_THETA = 10000.0
IN_COLS = S5_WIDTH + 4 * RET_WIDTH
D_FF = 2816
CONV_W = 3
NORM_EPS = 1e-6

kernel_name = "hybrid_s5_retention_convglu_dit_layer"


def rms_norm(t, w):
    tf = t.astype(jnp.float32)
    y = tf * lax.rsqrt(jnp.mean(tf * tf, axis=-1, keepdims=True) + NORM_EPS)
    return (y * w.astype(jnp.float32)).astype(t.dtype)


def adaln(cond, w_mod, b_mod):
    m = jax.nn.silu(cond) @ w_mod + b_mod
    return [t.reshape(-1, 1, D_MODEL) for t in jnp.split(m, 6, axis=-1)]


def modulate(h, shift, scale):
    return h * (1.0 + scale) + shift


def rope_2d(t):
    n_tok = t.shape[1]
    rows = n_tok // GRID_W
    row = jnp.repeat(jnp.arange(rows, dtype=jnp.float32), GRID_W)
    col = jnp.tile(jnp.arange(GRID_W, dtype=jnp.float32), rows)
    n_freq = RET_HEAD_DIM // 4
    inv_freq = ROPE_THETA ** (-jnp.arange(n_freq, dtype=jnp.float32) / n_freq)
    ang = jnp.concatenate([row[:, None] * inv_freq, col[:, None] * inv_freq], axis=-1)
    cos = jnp.cos(ang)[None, :, None, :]
    sin = jnp.sin(ang)[None, :, None, :]
    tf = t.astype(jnp.float32)
    t1, t2 = tf[..., 0::2], tf[..., 1::2]
    out = jnp.stack([t1 * cos - t2 * sin, t1 * sin + t2 * cos], axis=-1).reshape(t.shape)
    return out.astype(t.dtype)


def split_projection(p, rotate):
    b, n_tok, _ = p.shape
    u = p[..., :S5_WIDTH].reshape(b, n_tok, S5_GROUPS, S5_GROUP)
    q, k, v, g = jnp.split(p[..., S5_WIDTH:], 4, axis=-1)
    q = q.reshape(b, n_tok, RET_HEADS, RET_HEAD_DIM)
    k = k.reshape(b, n_tok, RET_HEADS, RET_HEAD_DIM) * (RET_HEAD_DIM ** -0.5)
    v = v.reshape(b, n_tok, RET_HEADS, RET_HEAD_DIM)
    if rotate:
        q = rope_2d(q)
        k = rope_2d(k)
    return (u, q.transpose(0, 2, 1, 3), k.transpose(0, 2, 1, 3), v.transpose(0, 2, 1, 3), g)


def s5_discretize(lam_re, lam_im, log_step, b_re, b_im):
    lam = lax.complex(lam_re.astype(jnp.float32), lam_im.astype(jnp.float32))
    step = jnp.exp(log_step.astype(jnp.float32))[:, None]
    lam_bar = jnp.exp(lam * step)
    b_mat = lax.complex(b_re.astype(jnp.float32), b_im.astype(jnp.float32))
    b_bar = ((lam_bar - 1.0) / lam)[..., None] * b_mat
    return lam_bar, b_bar


def _linear_combine(left, right):
    a_l, b_l = left
    a_r, b_r = right
    return a_r * a_l, a_r * b_l + b_r


def s5_scan(u, lam_bar, b_bar, h0, reverse):
    bu = jnp.einsum('gnp,blgp->blgn', b_bar, u.astype(jnp.float32).astype(jnp.complex64))
    if reverse:
        bu = jnp.flip(bu, axis=1)
    bu = bu.at[:, 0].add(lam_bar * h0)
    a = jnp.broadcast_to(lam_bar, bu.shape)
    _, h = lax.associative_scan(_linear_combine, (a, bu), axis=1)
    if reverse:
        h = jnp.flip(h, axis=1)
    return h


def s5_readout(u, h_f, h_b, c_re, c_im, d, w_glu, b_glu):
    b, n_tok = u.shape[0], u.shape[1]
    c_mat = lax.complex(c_re.astype(jnp.float32), c_im.astype(jnp.float32))
    y = jnp.real(jnp.einsum('gpn,blgn->blgp', c_mat, h_f + h_b))
    y = y + d.astype(jnp.float32).reshape(S5_GROUPS, S5_GROUP) * u.astype(jnp.float32)
    y = jax.nn.gelu(y.reshape(b, n_tok, S5_WIDTH))
    return y * jax.nn.sigmoid(y @ w_glu.astype(jnp.float32) + b_glu.astype(jnp.float32))


def retention_chunkwise(q, k, v, log_decay, r0, strict):
    b, h, n_tok, dk = q.shape
    dv = v.shape[-1]
    n_chunks = n_tok // RET_CHUNK
    ld = log_decay.astype(jnp.float32)
    qc = q.astype(jnp.float32).reshape(b, h, n_chunks, RET_CHUNK, dk)
    kc = k.astype(jnp.float32).reshape(b, h, n_chunks, RET_CHUNK, dk)
    vc = v.astype(jnp.float32).reshape(b, h, n_chunks, RET_CHUNK, dv)
    pos = jnp.arange(RET_CHUNK, dtype=jnp.float32)
    diff = pos[:, None] - pos[None, :]
    keep = diff > 0 if strict else diff >= 0
    intra_decay = jnp.where(keep, jnp.exp(ld[:, None, None] * jnp.maximum(diff, 0.0)), 0.0)
    scores = jnp.einsum('bhncd,bhnmd->bhncm', qc, kc) * intra_decay[None, :, None]
    intra = jnp.einsum('bhncm,bhnme->bhnce', scores, vc)
    zeta = jnp.exp(ld[:, None] * (RET_CHUNK - 1.0 - pos))
    chunk_kv = jnp.einsum('bhnmd,bhnme->nbhde', kc * zeta[None, :, None, :, None], vc)
    chunk_decay = jnp.exp(ld * RET_CHUNK)[None, :, None, None]

    def step(state, kv):
        return chunk_decay * state + kv, state

    _, r_prev = lax.scan(step, r0.astype(jnp.float32), chunk_kv)
    xi = jnp.exp(ld[:, None] * (pos + 1.0))
    cross = jnp.einsum('bhncd,nbhde->bhnce', qc * xi[None, :, None, :, None], r_prev)
    return (intra + cross).reshape(b, h, n_tok, dv)


def retention_final_state(k, v, log_decay):
    n_tok = k.shape[2]
    ld = log_decay.astype(jnp.float32)
    w = jnp.exp(ld[:, None] * (n_tok - 1.0 - jnp.arange(n_tok, dtype=jnp.float32)))
    return jnp.einsum('bhld,bhle->bhde', k.astype(jnp.float32) * w[None, :, :, None], v.astype(jnp.float32))


def retention_mixer(q, k, v, g, ld_f, ld_b, r0_f, r0_b):
    out_f = retention_chunkwise(q, k, v, ld_f, r0_f, strict=False)
    out_b = jnp.flip(retention_chunkwise(jnp.flip(q, 2), jnp.flip(k, 2), jnp.flip(v, 2), ld_b, r0_b, strict=True), 2)
    y = out_f + out_b
    mu = jnp.mean(y, axis=-1, keepdims=True)
    var = jnp.mean((y - mu) ** 2, axis=-1, keepdims=True)
    y = (y - mu) * lax.rsqrt(var + NORM_EPS)
    b, h, n_tok, dv = y.shape
    y = y.transpose(0, 2, 1, 3).reshape(b, n_tok, h * dv)
    return jax.nn.silu(g.astype(jnp.float32)) * y


def conv_ffn(h, w_up, conv_w, conv_b, w_down):
    a, g = jnp.split(h @ w_up, 2, axis=-1)
    n_tok = g.shape[1]
    half = CONV_W // 2
    gp = jnp.pad(g, ((0, 0), (half, half), (0, 0)))
    g_conv = conv_b + gp[:, 0:n_tok] * conv_w[0]
    for j in range(1, CONV_W):
        g_conv = g_conv + gp[:, j:j + n_tok] * conv_w[j]
    return (jax.nn.gelu(g_conv) * a) @ w_down


def setup_inputs(seed: int = 0) -> dict:
    key = jax.random.key(seed)
    ks = jax.random.split(key, 32)
    f32 = jnp.float32

    def nrm(k, shape, s):
        return s * jax.random.normal(k, shape, f32)

    gshape = (DEPTH, S5_GROUPS, S5_STATE)
    lam_re = -0.5 * jnp.ones(gshape, f32)
    lam_im = math.pi * jnp.broadcast_to(jnp.arange(S5_STATE, dtype=f32), gshape)

    def log_dt(k):
        return math.log(DT_MIN) + jax.random.uniform(k, (DEPTH, S5_GROUPS), f32) * (math.log(DT_MAX) - math.log(DT_MIN))

    base_decay = jnp.log(1.0 - 2.0 ** (-5.0 - jnp.arange(RET_HEADS, dtype=f32)))
    return {
        "x": nrm(ks[0], (BATCH, SEQ, D_MODEL), 1.0),
        "c": nrm(ks[1], (BATCH, D_MODEL), 1.0),
        "ctx": nrm(ks[2], (BATCH, CTX_LEN, D_MODEL), 1.0),
        "c_ctx": nrm(ks[3], (D_MODEL,), 1.0),
        "w_mod": nrm(ks[4], (DEPTH, D_MODEL, 6 * D_MODEL), 0.5 * D_MODEL ** -0.5),
        "b_mod": nrm(ks[5], (DEPTH, 6 * D_MODEL), 0.01),
        "norm1_w": 1.0 + nrm(ks[6], (DEPTH, D_MODEL), 0.02),
        "w_in": nrm(ks[7], (DEPTH, D_MODEL, IN_COLS), D_MODEL ** -0.5),
        "s5_lambda_re_f": lam_re + nrm(ks[8], gshape, 0.01),
        "s5_lambda_im_f": lam_im + nrm(ks[9], gshape, 0.01),
        "s5_log_step_f": log_dt(ks[10]),
        "s5_lambda_re_b": lam_re + nrm(ks[11], gshape, 0.01),
        "s5_lambda_im_b": lam_im + nrm(ks[12], gshape, 0.01),
        "s5_log_step_b": log_dt(ks[13]),
        "s5_b_re": nrm(ks[14], (DEPTH, S5_GROUPS, S5_STATE, S5_GROUP), (2.0 * S5_GROUP) ** -0.5),
        "s5_b_im": nrm(ks[15], (DEPTH, S5_GROUPS, S5_STATE, S5_GROUP), (2.0 * S5_GROUP) ** -0.5),
        "s5_c_re": nrm(ks[16], (DEPTH, S5_GROUPS, S5_GROUP, S5_STATE), 0.5),
        "s5_c_im": nrm(ks[17], (DEPTH, S5_GROUPS, S5_GROUP, S5_STATE), 0.5),
        "s5_d": nrm(ks[18], (DEPTH, S5_WIDTH), 0.5),
        "s5_w_glu": nrm(ks[19], (DEPTH, S5_WIDTH, S5_WIDTH), S5_WIDTH ** -0.5),
        "s5_b_glu": nrm(ks[20], (DEPTH, S5_WIDTH), 0.01),
        "ret_log_decay_f": base_decay * jnp.exp(nrm(ks[21], (DEPTH, RET_HEADS), 0.05)),
        "ret_log_decay_b": base_decay * jnp.exp(nrm(ks[22], (DEPTH, RET_HEADS), 0.05)),
        "w_out": nrm(ks[23], (DEPTH, D_MODEL, D_MODEL), D_MODEL ** -0.5),
        "norm2_w": 1.0 + nrm(ks[24], (DEPTH, D_MODEL), 0.02),
        "w_up": nrm(ks[25], (DEPTH, D_MODEL, 2 * D_FF), D_MODEL ** -0.5),
        "conv_w": nrm(ks[26], (DEPTH, CONV_W, D_FF), CONV_W ** -0.5),
        "conv_b": nrm(ks[27], (DEPTH, D_FF), 0.01),
        "w_down": nrm(ks[28], (DEPTH, D_FF, D_MODEL), D_FF ** -0.5),
        "final_norm_w": 1.0 + nrm(ks[29], (D_MODEL,), 0.02),
    }


def reference(x, c, ctx, c_ctx, w_mod, b_mod, norm1_w, w_in,
              s5_lambda_re_f, s5_lambda_im_f, s5_log_step_f,
              s5_lambda_re_b, s5_lambda_im_b, s5_log_step_b,
              s5_b_re, s5_b_im, s5_c_re, s5_c_im, s5_d, s5_w_glu, s5_b_glu,
              ret_log_decay_f, ret_log_decay_b, w_out,
              norm2_w, w_up, conv_w, conv_b, w_down, final_norm_w):
    batch = x.shape[0]
    zero_s5 = jnp.zeros((batch, S5_GROUPS, S5_STATE), jnp.complex64)
    zero_ret = jnp.zeros((batch, RET_HEADS, RET_HEAD_DIM, RET_HEAD_DIM), jnp.float32)
    for layer in range(DEPTH):
        mx = adaln(c, w_mod[layer], b_mod[layer])
        mc = adaln(c_ctx, w_mod[layer], b_mod[layer])
        hx = modulate(rms_norm(x, norm1_w[layer]), mx[0], mx[1])
        hc = modulate(rms_norm(ctx, norm1_w[layer]), mc[0], mc[1])
        ux, qx, kx, vx, gx = split_projection(hx @ w_in[layer], rotate=True)
        uc, qc, kc, vc, gc = split_projection(hc @ w_in[layer], rotate=False)
        lam_f, bbar_f = s5_discretize(s5_lambda_re_f[layer], s5_lambda_im_f[layer], s5_log_step_f[layer], s5_b_re[layer], s5_b_im[layer])
        lam_b, bbar_b = s5_discretize(s5_lambda_re_b[layer], s5_lambda_im_b[layer], s5_log_step_b[layer], s5_b_re[layer], s5_b_im[layer])
        hc_f = s5_scan(uc, lam_f, bbar_f, zero_s5, reverse=False)
        hc_b = s5_scan(uc, lam_b, bbar_b, zero_s5, reverse=True)
        rc_f = retention_final_state(kc, vc, ret_log_decay_f[layer])
        rc_b = retention_final_state(jnp.flip(kc, 2), jnp.flip(vc, 2), ret_log_decay_b[layer])
        hx_f = s5_scan(ux, lam_f, bbar_f, hc_f[:, -1], reverse=False)
        hx_b = s5_scan(ux, lam_b, bbar_b, hc_b[:, 0], reverse=True)
        s5_x = s5_readout(ux, hx_f, hx_b, s5_c_re[layer], s5_c_im[layer], s5_d[layer], s5_w_glu[layer], s5_b_glu[layer])
        ret_x = retention_mixer(qx, kx, vx, gx, ret_log_decay_f[layer], ret_log_decay_b[layer], rc_f, rc_b)
        mix_x = jnp.concatenate([s5_x, ret_x], axis=-1).astype(x.dtype) @ w_out[layer]
        x = x + mx[2] * mix_x
        hx2 = modulate(rms_norm(x, norm2_w[layer]), mx[3], mx[4])
        x = x + mx[5] * conv_ffn(hx2, w_up[layer], conv_w[layer], conv_b[layer], w_down[layer])
        if layer < DEPTH - 1:
            s5_c = s5_readout(uc, hc_f, hc_b, s5_c_re[layer], s5_c_im[layer], s5_d[layer], s5_w_glu[layer], s5_b_glu[layer])
            ret_c = retention_mixer(qc, kc, vc, gc, ret_log_decay_f[layer], ret_log_decay_b[layer], zero_ret, zero_ret)
            ctx = ctx + mc[2] * (jnp.concatenate([s5_c, ret_c], axis=-1).astype(ctx.dtype) @ w_out[layer])
            hc2 = modulate(rms_norm(ctx, norm2_w[layer]), mc[3], mc[4])
            ctx = ctx + mc[5] * conv_ffn(hc2, w_up[layer], conv_w[layer], conv_b[layer], w_down[layer])
    return rms_norm(x, final_norm_w)
```

```cpp
#include <hip/hip_runtime.h>
#include <hip/hip_cooperative_groups.h>
#include <cstdio>
#include <cstdint>
namespace cg = cooperative_groups;

#define LAS __attribute__((address_space(3)))
typedef unsigned short bf16_t;
typedef short bf16x8 __attribute__((ext_vector_type(8)));
typedef float f32x4 __attribute__((ext_vector_type(4)));
typedef float f32x2 __attribute__((ext_vector_type(2)));
typedef unsigned u32x4 __attribute__((ext_vector_type(4)));
typedef unsigned u32x2 __attribute__((ext_vector_type(2)));

constexpr int D = 1024, SEQ = 8192, NB = 2, MLAT = NB * SEQ, CTXL = 256, MCTX = NB * CTXL, MALL = MLAT + MCTX;
constexpr int INC = 2560, DFF = 2816, DFF2 = 5632;
constexpr float EPS = 1e-6f;

constexpr size_t MiB = 1u << 20;
constexpr size_t WS_WIN = 0, WS_S5E = 7 * MiB + MiB / 2, WS_S5WY = 11 * MiB + MiB / 2;
constexpr size_t WS_WUP = 0, WS_WDOWN = 11 * MiB;
constexpr size_t WS_XN = 22 * MiB;
constexpr size_t WS_US = 55 * MiB;
constexpr size_t WS_QB = 95 * MiB, WS_KB = 111 * MiB, WS_GB = 127 * MiB;
constexpr size_t WS_KW = 143 * MiB;
constexpr size_t WS_BTU = 177 * MiB;
constexpr size_t WS_SST = 211 * MiB;
constexpr size_t WS_KVT = 232 * MiB;
constexpr size_t WS_HAG = 55 * MiB;
constexpr size_t WS_BAR = 251 * MiB;
constexpr size_t CTL_BYTES = 65536;
constexpr size_t WS_CNT = WS_BAR + 16384;
constexpr size_t WS_TAB = 251 * MiB + 65536;
constexpr size_t WS_MODP = WS_TAB, WS_MOD = WS_MODP + 8 * 3 * 6144 * 4, WS_ROPE = WS_MOD + 3 * 6144 * 4, WS_L16 = WS_ROPE + 128 * 32 * 8;
constexpr size_t WS_KT = 252 * MiB;
constexpr size_t WS_WOUT = 253 * MiB, WS_WGLU = 255 * MiB;
constexpr size_t WS_XCH = 255 * MiB + MiB / 2;
static_assert(WS_L16 + 32 * 2 * 64 * 8 <= WS_KT, "tables");
static_assert(WS_HAG + (size_t)MLAT * DFF2 * 2 <= 256 * MiB, "ws");

#ifndef REPM
#define REPM 0
#endif
#ifndef NXSYNC
#define NXSYNC 0
#endif
#ifndef SUB
#define SUB 7
#endif
#ifndef PM
#define PM 0xFFFF
#endif

#define XB_TMO      128
#define XB_XCNT(j)  (256  + 64 * (j))
#define XB_XSUB(j)  (1280 + 64 * (j))
#define XB_XGEN(j)  (2304 + 64 * (j))
#define XB_TOP      3328
#define XB_TOPGEN   3392
#define XCD_BAR_WORDS 3456
#define XB_SPIN_CAP (1u << 18)
__device__ __forceinline__ unsigned xb_ld(unsigned* p)              { return __hip_atomic_load(p, __ATOMIC_RELAXED, __HIP_MEMORY_SCOPE_AGENT); }
__device__ __forceinline__ unsigned xb_add(unsigned* p, unsigned v) { return __hip_atomic_fetch_add(p, v, __ATOMIC_RELAXED, __HIP_MEMORY_SCOPE_AGENT); }
__device__ __forceinline__ unsigned xb_xcc_id() { return (unsigned)__builtin_amdgcn_s_getreg((3 << 11) | 20) & 0xFu; }
#define XB_SPIN(cond, bar) do { unsigned _sp = 0; while (cond) { __builtin_amdgcn_s_sleep(1); \
    if ((++_sp & 255u) == 0u) { if (xb_ld(&(bar)[XB_TMO])) break; if (_sp > XB_SPIN_CAP) { atomicAdd(&(bar)[XB_TMO], 1u); break; } } } } while (0)
struct XcdBarrier { unsigned* bar; unsigned x; volatile LAS unsigned* st; };
__device__ __forceinline__ XcdBarrier xcd_barrier_post(unsigned* bar, volatile LAS unsigned* st) {
    XcdBarrier b; b.bar = bar; b.x = xb_xcc_id(); b.st = st;
    if (threadIdx.x == 0) (void)xb_add(&bar[XB_XCNT(b.x)], 1u);
    return b;
}
__device__ __forceinline__ void xcd_barrier_complete(unsigned* bar, unsigned x, unsigned& nloc, unsigned& nx) {
    const unsigned G = gridDim.x * gridDim.y * gridDim.z;
    unsigned sum, cnt, mine, sp = 0u;
    for (;;) {
        sum = 0u; cnt = 0u; mine = 0u;
#pragma unroll
        for (unsigned j = 0; j < 16; ++j) { const unsigned c = xb_ld(&bar[XB_XCNT(j)]); sum += c; cnt += (c > 0u) ? 1u : 0u; mine = (j == x) ? c : mine; }
        if (sum == G) break;
        __builtin_amdgcn_s_sleep(1);
        if ((++sp & 255u) == 0u) { if (xb_ld(&bar[XB_TMO])) break; if (sp > XB_SPIN_CAP) { atomicAdd(&bar[XB_TMO], 1u); break; } }
    }
    nloc = mine > 0u ? mine : 1u; nx = cnt > 0u ? cnt : 1u;
}
__device__ __forceinline__ void xcd_barrier(const XcdBarrier& b) {
    asm volatile("s_waitcnt vmcnt(0)" ::: "memory");
    __syncthreads();
    if (threadIdx.x == 0) {
        unsigned* bar = b.bar;
        __builtin_amdgcn_s_waitcnt(0);
        unsigned nloc = b.st[0], nx = b.st[1];
        if (nloc == 0u) { xcd_barrier_complete(bar, b.x, nloc, nx); b.st[0] = nloc; b.st[1] = nx; }
        const unsigned old = xb_add(&bar[XB_XSUB(b.x)], 1u);
        const unsigned gen = old / nloc;
        if (old + 1u == (gen + 1u) * nloc) {
            __builtin_amdgcn_fence(__ATOMIC_RELEASE, "agent");
            asm volatile("s_waitcnt vmcnt(0)" ::: "memory");
            const unsigned og = xb_add(&bar[XB_TOP], 1u);
            const unsigned tg = og / nx;
            if (og + 1u == (tg + 1u) * nx) xb_add(&bar[XB_TOPGEN], 1u);
            else XB_SPIN(xb_ld(&bar[XB_TOPGEN]) == tg, bar);
            __builtin_amdgcn_fence(__ATOMIC_ACQUIRE, "agent");
            xb_add(&bar[XB_XGEN(b.x)], 1u);
            asm volatile("s_waitcnt vmcnt(0)" ::: "memory");
        } else {
            XB_SPIN(xb_ld(&bar[XB_XGEN(b.x)]) == gen, bar);
            __builtin_amdgcn_fence(__ATOMIC_ACQUIRE, "agent");
            asm volatile("s_waitcnt vmcnt(0)" ::: "memory");
        }
    }
    __syncthreads();
}

struct Params { const float* in[30]; float* out; unsigned char* ws; };

__device__ __forceinline__ unsigned cvt_pk_bf16(float lo, float hi) { unsigned r; asm("v_cvt_pk_bf16_f32 %0, %1, %2" : "=v"(r) : "v"(lo), "v"(hi)); return r; }
__device__ __forceinline__ bf16_t f2bf(float x) { return (bf16_t)(cvt_pk_bf16(x, x) & 0xffffu); }
__device__ __forceinline__ u32x4 pk8(f32x4 lo, f32x4 hi) { u32x4 w; w.x = cvt_pk_bf16(lo[0], lo[1]); w.y = cvt_pk_bf16(lo[2], lo[3]); w.z = cvt_pk_bf16(hi[0], hi[1]); w.w = cvt_pk_bf16(hi[2], hi[3]); return w; }
__device__ __forceinline__ void unpk8(u32x4 w, f32x4& lo, f32x4& hi) {
    lo[0] = __uint_as_float(w.x << 16); lo[1] = __uint_as_float(w.x & 0xffff0000u); lo[2] = __uint_as_float(w.y << 16); lo[3] = __uint_as_float(w.y & 0xffff0000u);
    hi[0] = __uint_as_float(w.z << 16); hi[1] = __uint_as_float(w.z & 0xffff0000u); hi[2] = __uint_as_float(w.w << 16); hi[3] = __uint_as_float(w.w & 0xffff0000u);
}
__device__ __forceinline__ float bf2f(bf16_t h) { return __uint_as_float(((unsigned)h) << 16); }
__device__ __forceinline__ float sigmoidf_(float w) { return __builtin_amdgcn_rcpf(1.0f + __builtin_amdgcn_exp2f(w * -1.4426950408889634f)); }
__device__ __forceinline__ float gelu_tanh(float x) { const float t = x * x, u = fmaf(t, -2.3022081981f * 0.044715f, -2.3022081981f);
    return x * __builtin_amdgcn_rcpf(1.0f + __builtin_amdgcn_exp2f(x * u)); }
__device__ __forceinline__ f32x4 gelu_tanh4(f32x4 x) {
    const f32x4 t = x * x, u = t * (-2.3022081981f * 0.044715f) + (-2.3022081981f), w = x * u;
    f32x4 e; e[0] = __builtin_amdgcn_exp2f(w[0]); e[1] = __builtin_amdgcn_exp2f(w[1]); e[2] = __builtin_amdgcn_exp2f(w[2]); e[3] = __builtin_amdgcn_exp2f(w[3]);
    const f32x4 d = e + 1.0f;
    f32x4 r; r[0] = __builtin_amdgcn_rcpf(d[0]); r[1] = __builtin_amdgcn_rcpf(d[1]); r[2] = __builtin_amdgcn_rcpf(d[2]); r[3] = __builtin_amdgcn_rcpf(d[3]);
    return x * r;
}
__device__ __forceinline__ float silu_(float x) { return x * sigmoidf_(x); }
__device__ __forceinline__ float wave_sum(float v) {
#pragma unroll
    for (int o = 1; o < 64; o <<= 1) v += __shfl_xor(v, o);
    return v;
}
__device__ __forceinline__ void sincos_red(float th, float& s, float& c) {
    const float k = rintf(th * 0.15915494309189535f);
    float r = fmaf(-k, 6.28125f, th);
    r = fmaf(-k, 1.9353071795864769e-3f, r);
    sincosf(r, &s, &c);
}

constexpr int BM = 256, BK = 64, HALF = 128, HTB = HALF * BK * 2, STAGE_BYTES = 8 * HTB, NXCD = 8, WGM = 8;
__device__ __forceinline__ int lds_byte(int r, int c) { const int st = (r >> 4) * 2 + (c >> 5), rr = r & 15, cc = c & 31, ob = rr * 64 + cc * 2; return st * 1024 + (ob ^ (((ob >> 9) & 1) << 5)); }
__device__ __forceinline__ void stage_rc(int b, int& R, int& C) { const int st = b / 1024, sb = b % 1024, swz = sb ^ (((sb >> 9) & 1) << 5); R = (st >> 1) * 16 + swz / 64; C = (st & 1) * 32 + (swz % 64) / 2; }
__device__ __forceinline__ int perm32(int rho) { const int n = rho >> 4, i = rho & 15; return 8 * (i >> 2) + 4 * n + (i & 3); }

struct Unit { int pm, pn; const char* a; const char* b; int nt, ty; };

template <class Epi, class Sched>
__device__ __forceinline__ void gemm_phase(LAS unsigned char* lds, const int lda, const int ldb, const int K, const Sched& S, const Epi& E) {
    int tid_ = threadIdx.x; asm volatile("" : "+v"(tid_));
    const int tid = tid_, wid = __builtin_amdgcn_readfirstlane(tid >> 6), lane = tid & 63, wr = wid >> 2, wc = wid & 3, fr = lane & 15, fq = lane >> 4;
    const int nt_call = K / BK;
    unsigned voffA[2], voffB[2];
#pragma unroll
    for (int i = 0; i < 2; ++i) { int R, C; stage_rc(tid * 16 + i * 8192, R, C); const int Rb = (R & ~31) + perm32(R & 31);
        voffA[i] = (unsigned)(R * lda + C) * 2u; voffB[i] = (unsigned)(Rb * ldb + C) * 2u; }
    const size_t kstep = (size_t)(BK * 2);
    const size_t hstepA = (size_t)HALF * lda * 2, hstepB = (size_t)HALF * ldb * 2;
    const unsigned ldsw = (unsigned)wid * 1024u;
    const int aoff = lds_byte(wr * 64 + fr, fq * 8), boff = lds_byte(wc * 32 + fr, fq * 8);
#define PG8_SA(b, h) (((b) * 2 + (h)) * HTB)
#define PG8_SB(b, h) ((4 + (b) * 2 + (h)) * HTB)
#define PG8_STAGE(bufoff, gbase, voff) do { _Pragma("unroll") for (int _i = 0; _i < 2; ++_i) \
        __builtin_amdgcn_global_load_lds((const unsigned*)((const char*)(gbase) + (voff)[_i]), (LAS unsigned*)(lds + (bufoff) + ldsw + _i * 8192), 16, 0, 0); } while (0)
#define PG8_LDA(dst, b, h) do { _Pragma("unroll") for (int m = 0; m < 4; ++m) _Pragma("unroll") for (int k = 0; k < 2; ++k) dst[m][k] = *(const LAS bf16x8*)(lds + PG8_SA(b, h) + aoff + m * 2048 + k * 1024); } while (0)
#define PG8_LDB(dst, b, h) do { _Pragma("unroll") for (int n = 0; n < 2; ++n) _Pragma("unroll") for (int k = 0; k < 2; ++k) dst[n][k] = *(const LAS bf16x8*)(lds + PG8_SB(b, h) + boff + n * 2048 + k * 1024); } while (0)
#define PG8_MMA(ai, bj, At, Bt) do { __builtin_amdgcn_s_setprio(1); _Pragma("unroll") for (int m = 0; m < 4; ++m) _Pragma("unroll") for (int n = 0; n < 2; ++n) _Pragma("unroll") for (int k = 0; k < 2; ++k) \
        acc[ai][bj][m][n] = __builtin_amdgcn_mfma_f32_16x16x32_bf16(Bt[n][k], At[m][k], acc[ai][bj][m][n], 0, 0, 0); __builtin_amdgcn_s_setprio(0); } while (0)
#define PG8_WAIT_V(n) asm volatile("s_waitcnt vmcnt(" #n ")" ::: "memory")
#define PG8_WAIT_L(n) asm volatile("s_waitcnt lgkmcnt(" #n ")" ::: "memory")
#define PG8_BAR __builtin_amdgcn_s_barrier()
#define PG8_SCHED __builtin_amdgcn_sched_barrier(0)
    Unit cur, nxt; int ui = 0;
    cur.nt = 0; cur.ty = 0; nxt.nt = 0; nxt.ty = 0;
    if (!S.next(0, cur)) return;
    f32x4 acc[2][2][4][2];
#pragma unroll
    for (int a = 0; a < 2; ++a)
#pragma unroll
        for (int b = 0; b < 2; ++b)
#pragma unroll
            for (int m = 0; m < 4; ++m)
#pragma unroll
                for (int n = 0; n < 2; ++n) acc[a][b][m][n] = (f32x4){0.f, 0.f, 0.f, 0.f};
    bf16x8 At[4][2], B0[2][2], B1[2][2];
    const char* cA = cur.a; const char* cB = cur.b;
    PG8_STAGE(PG8_SB(0, 0), cB, voffB); PG8_STAGE(PG8_SB(0, 1), cB + hstepB, voffB); PG8_STAGE(PG8_SA(0, 0), cA, voffA); PG8_STAGE(PG8_SA(0, 1), cA + hstepA, voffA);
    if (wr == 1) PG8_BAR;
    PG8_WAIT_V(2); PG8_BAR;
    PG8_STAGE(PG8_SB(1, 0), cB + kstep, voffB); PG8_STAGE(PG8_SA(1, 0), cA + kstep, voffA); PG8_STAGE(PG8_SB(1, 1), cB + hstepB + kstep, voffB);
    PG8_WAIT_V(6); PG8_BAR;
    for (;;) {
        nxt.nt = 0; nxt.ty = 0;
        const bool has_next = S.next(ui + 1, nxt);
        const int nt = cur.nt ? cur.nt : nt_call;
        const char* nA = has_next ? nxt.a : cA; const char* nB = has_next ? nxt.b : cB;
        for (int t = 0; t < nt; t += 2) {
            const bool last = (t == nt - 2);
            const char* a1 = cA + (size_t)(t + 1) * kstep;
            const char* a2 = last ? nA : cA + (size_t)(t + 2) * kstep; const char* b2 = last ? nB : cB + (size_t)(t + 2) * kstep;
            const char* a3 = a2 + kstep; const char* b3 = b2 + kstep;
            PG8_LDB(B0, 0, 0); PG8_LDB(B1, 0, 1); PG8_SCHED; PG8_LDA(At, 0, 0); PG8_STAGE(PG8_SA(1, 1), a1 + hstepA, voffA);
            PG8_WAIT_V(8); PG8_WAIT_L(0); PG8_BAR; PG8_MMA(0, 0, At, B0); PG8_MMA(0, 1, At, B1); PG8_BAR; PG8_SCHED;
            PG8_LDA(At, 0, 1); PG8_STAGE(PG8_SB(0, 0), b2, voffB); PG8_STAGE(PG8_SB(0, 1), b2 + hstepB, voffB); PG8_STAGE(PG8_SA(0, 0), a2, voffA);
            PG8_WAIT_V(8); PG8_WAIT_L(0); PG8_BAR; PG8_MMA(1, 0, At, B0); PG8_MMA(1, 1, At, B1); PG8_BAR; PG8_SCHED;
            PG8_LDB(B0, 1, 0); PG8_LDB(B1, 1, 1); PG8_SCHED; PG8_LDA(At, 1, 0); PG8_STAGE(PG8_SA(0, 1), a2 + hstepA, voffA);
            PG8_WAIT_V(8); PG8_WAIT_L(0); PG8_BAR; PG8_MMA(0, 0, At, B0); PG8_MMA(0, 1, At, B1); PG8_BAR; PG8_SCHED;
            PG8_LDA(At, 1, 1); PG8_STAGE(PG8_SB(1, 0), b3, voffB); PG8_STAGE(PG8_SB(1, 1), b3 + hstepB, voffB); PG8_STAGE(PG8_SA(1, 0), a3, voffA);
            PG8_WAIT_V(8); PG8_WAIT_L(0); PG8_BAR; PG8_MMA(1, 0, At, B0); PG8_MMA(1, 1, At, B1); PG8_BAR; PG8_SCHED;
        }
        if (wr == 0) PG8_BAR;
        if constexpr (!Epi::AFTER_DRAIN) { int fr_ = fr, fq_ = fq, wr_ = wr, wc_ = wc; asm volatile("" : "+v"(fr_), "+v"(fq_), "+s"(wr_), "+s"(wc_));
          E(acc, cur, wr_, wc_, fr_, fq_); }
        if (!has_next) break;
#pragma unroll
        for (int a = 0; a < 2; ++a)
#pragma unroll
            for (int b = 0; b < 2; ++b)
#pragma unroll
                for (int m = 0; m < 4; ++m)
#pragma unroll
                    for (int n = 0; n < 2; ++n) acc[a][b][m][n] = (f32x4){0.f, 0.f, 0.f, 0.f};
        cur = nxt; cA = nA; cB = nB; ++ui;
        if (wr == 1) PG8_BAR;
    }
    PG8_WAIT_V(0);
    PG8_BAR;
    if constexpr (Epi::AFTER_DRAIN) {
        int fr_ = fr, fq_ = fq, wr_ = wr, wc_ = wc, ln_ = lane; asm volatile("" : "+v"(fr_), "+v"(fq_), "+s"(wr_), "+s"(wc_), "+v"(ln_));
        E.fused(acc, cur, wr_, wc_, fr_, fq_, lds, wid, ln_); }
#undef PG8_SA
#undef PG8_SB
#undef PG8_STAGE
#undef PG8_LDA
#undef PG8_LDB
#undef PG8_MMA
#undef PG8_WAIT_V
#undef PG8_WAIT_L
#undef PG8_BAR
#undef PG8_SCHED
}

#define EPI_LOOP_BEGIN \
    _Pragma("unroll") for (int ai = 0; ai < 2; ++ai) _Pragma("unroll") for (int m = 0; m < 4; ++m) { const int rl = ai * 128 + wr * 64 + m * 16 + fr; \
    _Pragma("unroll") for (int bj = 0; bj < 2; ++bj) { const int cl = bj * 128 + wc * 32 + 8 * fq; f32x4 lo = acc[ai][bj][m][0], hi = acc[ai][bj][m][1];
#define EPI_LOOP_END } }

struct SchedStatic {
    int nM, nN, nwg, G, c; const char* A; const char* B; size_t ta, tb;
    __device__ __forceinline__ void init(int M, int N, int lda, int ldb, const void* A_, const void* B_, int G_, int c_) { nM = M / BM; nN = N / BM; nwg = nM * nN; G = G_; c = c_; A = (const char*)A_; B = (const char*)B_; ta = (size_t)BM * lda * 2; tb = (size_t)BM * ldb * 2; }
    __device__ __forceinline__ bool next(int i, Unit& u) const {
        const long L = (long)i * G + c; if (L >= nwg) return false;
        int wgid = (int)L; { const int q = nwg / NXCD, r = nwg % NXCD, xcd = wgid % NXCD, off = wgid / NXCD; wgid = (xcd < r ? xcd * (q + 1) : r * (q + 1) + (xcd - r) * q) + off; }
        const int nig = WGM * nN, gid = wgid / nig, fm = gid * WGM, gsz = (nM - fm) < WGM ? (nM - fm) : WGM;
        u.pm = fm + ((wgid % nig) % gsz); u.pn = (wgid % nig) / gsz; u.a = A + (size_t)u.pm * ta; u.b = B + (size_t)u.pn * tb; return true;
    }
};
struct SchedIn {
    int nM, nN, nwg, G, c, o1, o2; const char* A; const char* B;
    int t0, t1, tb;
    __device__ __forceinline__ bool next(int i, Unit& u) const {
        if (c < 0) return false;
        const long L = (long)i * G + c;
        if (L >= nwg) { const int t = t0 + (int)(L - nwg); if (t >= t1) return false;
            u.pm = t & 63; u.pn = tb + (t >> 6); u.a = A + (size_t)u.pm * (256 * 1024 * 2); u.b = B + (size_t)u.pn * (256 * 1024 * 2); return true; }
        int wgid = (int)L; { const int q = nwg / NXCD, r = nwg % NXCD, xcd = wgid % NXCD, off = wgid / NXCD; wgid = (xcd < r ? xcd * (q + 1) : r * (q + 1) + (xcd - r) * q) + off; }
        const int nig = WGM * nN, gid = wgid / nig, fm = gid * WGM, gsz = (nM - fm) < WGM ? (nM - fm) : WGM;
        u.pm = fm + ((wgid % nig) % gsz); const int j = (wgid % nig) / gsz; u.pn = (nN == 6) ? (j < 4 ? j + 4 : j - 4) : j + (j < 2 ? o1 : o2);
        u.a = A + (size_t)u.pm * (256 * 1024 * 2); u.b = B + (size_t)u.pn * (256 * 1024 * 2); return true;
    }
};
struct SchedP3 {
    int G, c, base, lim; const char* QB; const char* KB; const char* BTU; const char* KW; const char* US; const char* S5E;
    __device__ __forceinline__ bool next(int i, Unit& u) const {
        if (c < 0) return false;
        int L = base + i * G + c; if (L >= lim) return false;
        if (L < 256) { const int bh = L >> 5, cc = L & 31, b = bh >> 2, h = bh & 3;
            u.pm = L; u.pn = h; u.nt = 2; u.ty = 0;
            u.a = QB + ((size_t)L * 256 * 512 + 256) * 2; u.b = KB + (((size_t)((b * 2 + (h >> 1)) * SEQ + cc * 256)) * 256 + (h & 1) * 128) * 2; return true; }
        L -= 256;
        if (L < 264) { u.pm = L; u.pn = 0; u.nt = 4; u.ty = 1; u.a = BTU + (size_t)L * 131072; u.b = KW + (size_t)L * 131072; return true; }
        L -= 264;
        if (L < 160) { const int g = L / 5, pml = L % 5; u.pm = pml; u.pn = g; u.nt = 4; u.ty = 2;
            u.a = US + ((size_t)(g * 1280 + pml * 256) * 512) * 2; u.b = S5E + (size_t)g * 256 * 256 * 2; return true; }
        return false;
    }
};
struct SchedO {
    int G, c, base, lim; const char* A2U; const char* BTU;
    __device__ __forceinline__ bool next(int i, Unit& u) const {
        if (c < 0) return false;
        const int L = base + i * G + c; if (L >= lim) return false;
        const int bh = L >> 5, cc = L & 31; u.pm = L; u.pn = bh & 3; u.a = A2U + (size_t)L * 262144; u.b = BTU + (size_t)(bh * 33 + cc) * 131072; return true; }
};
struct SchedY {
    int G, c; const char* US; const char* WY;
    __device__ __forceinline__ bool next(int i, Unit& u) const {
        if (c < 0) return false;
        const int L = i * G + c; if (L >= 128) return false;
        const int g = L >> 2, pml = L & 3; u.pm = pml; u.pn = g; u.a = US + ((size_t)(g * 1280 + pml * 256) * 512) * 2; u.b = WY + (size_t)g * 256 * 512 * 2; return true; }
};

__device__ __forceinline__ void rope8(f32x4& lo, f32x4& hi, const f32x2* rope, int t, int d) {
    const int j0 = d >> 1, pos = (j0 < 32) ? (t >> 6) : (t & 63);
    const f32x4* cs = (const f32x4*)(rope + pos * 32 + (j0 & 31));
    const f32x4 c01 = cs[0], c23 = cs[1];
    float a, b;
    a = lo[0]; b = lo[1]; lo[0] = a * c01[0] - b * c01[1]; lo[1] = a * c01[1] + b * c01[0];
    a = lo[2]; b = lo[3]; lo[2] = a * c01[2] - b * c01[3]; lo[3] = a * c01[3] + b * c01[2];
    a = hi[0]; b = hi[1]; hi[0] = a * c23[0] - b * c23[1]; hi[1] = a * c23[1] + b * c23[0];
    a = hi[2]; b = hi[3]; hi[2] = a * c23[2] - b * c23[3]; hi[3] = a * c23[3] + b * c23[2];
}


__device__ __forceinline__ unsigned dpp_swap1(unsigned v) { return (unsigned)__builtin_amdgcn_update_dpp(0, (int)v, 0xB1, 0xf, 0xf, false); }
__device__ __forceinline__ void pair_pack(f32x4 lo, f32x4 hi, bool odd, unsigned (&o)[4]) {
    const unsigned p01 = cvt_pk_bf16(lo[0], lo[1]), p23 = cvt_pk_bf16(lo[2], lo[3]), p45 = cvt_pk_bf16(hi[0], hi[1]), p67 = cvt_pk_bf16(hi[2], hi[3]);
    const unsigned r0 = dpp_swap1(odd ? p01 : p45), r1 = dpp_swap1(odd ? p23 : p67);
    const unsigned kA = odd ? p45 : p01, kB = odd ? p67 : p23;
    const unsigned eA = odd ? r0 : kA, oA = odd ? kA : r0, eB = odd ? r1 : kB, oB = odd ? kB : r1;
    o[0] = (eA & 0xffffu) | (oA << 16); o[1] = (eA >> 16) | (oA & 0xffff0000u); o[2] = (eB & 0xffffu) | (oB << 16); o[3] = (eB >> 16) | (oB & 0xffff0000u);
}
struct EpiIn {
    static constexpr bool AFTER_DRAIN = false;
    bf16_t *US, *QB, *KB, *GB, *KW, *BTU, *A2U; const f32x2* rope; const float* ldf; const float* ldb;
    __device__ __forceinline__ void operator()(const f32x4 (&acc)[2][2][4][2], const Unit& u, int wr, int wc, int fr, int fq) const {
        const int region = u.pn >> 1; const bool isctx = u.pm >= 64;
        if (isctx && (region == 1 || region == 4)) return;
        const int cb = (u.pn & 1) * 256;
        if (region == 0) {
            EPI_LOOP_BEGIN
                const int r = u.pm * 256 + rl; int b, t;
                if (!isctx) { b = r >> 13; t = r & 8191; } else { const int rc = r - MLAT; b = rc >> 8; t = rc & 255; }
                const int c = cb + cl, g = c >> 4, p0 = c & 15;
                const int crow = isctx ? (1024 + b * 16 + (t >> 4)) : (b * 512 + (t >> 4));
                *(u32x4*)(US + ((size_t)(g * 1280 + crow) * 512 + (t & 15) * 16 + p0)) = pk8(lo, hi);
            EPI_LOOP_END
        } else if (region == 1) {
            EPI_LOOP_BEGIN
                const int r = u.pm * 256 + rl, b = r >> 13, t = r & 8191;
                const int c = cb + cl, h = c >> 7, d = c & 127;
                rope8(lo, hi, rope, t, d);
                const int u2 = (b * 4 + h) * 32 + (t >> 8), cc = t & 255;
                const float wf = __expf(ldf[h] * (float)(cc + 1)), wb = __expf(ldb[h] * (float)(256 - cc));
                bf16_t* dst = A2U + ((size_t)u2 * 256 + cc) * 512 + 256 + d;
                *(u32x4*)dst = pk8(lo * wf, hi * wf);
                *(u32x4*)(dst + 128) = pk8(lo * wb, hi * wb);
            EPI_LOOP_END
        } else if (region == 2) {
            EPI_LOOP_BEGIN
                const int r = u.pm * 256 + rl; int b, t;
                if (!isctx) { b = r >> 13; t = r & 8191; } else { const int rc = r - MLAT; b = rc >> 8; t = rc & 255; }
                const int c = cb + cl, h = c >> 7, d = c & 127;
                lo = lo * 0.08838834764831845f; hi = hi * 0.08838834764831845f;
                int ku, mm;
                if (!isctx) { rope8(lo, hi, rope, t, d); *(u32x4*)(KB + ((size_t)((b * 2 + (h >> 1)) * SEQ + t)) * 256 + (h & 1) * 128 + d) = pk8(lo, hi); ku = (b * 4 + h) * 33 + (t >> 8); mm = t & 255; }
                else { ku = (b * 4 + h) * 33 + 32; mm = t; }
                const float wf = __expf(ldf[h] * (float)(255 - mm)), wb = __expf(ldb[h] * (float)mm);
                const bool odd = fr & 1; unsigned pf[4], pb[4];
                pair_pack(lo * wf, hi * wf, odd, pf); pair_pack(lo * wb, hi * wb, odd, pb);
                bf16_t* dst = KW + ((size_t)ku * 256 + d + (odd ? 4 : 0)) * 256 + (mm & ~1);
#pragma unroll
                for (int i = 0; i < 4; ++i) { *(unsigned*)(dst + i * 256) = pf[i]; *(unsigned*)(dst + (128 + i) * 256) = pb[i]; }
            EPI_LOOP_END
        } else if (region == 3) {
            EPI_LOOP_BEGIN
                const int r = u.pm * 256 + rl; int b, t;
                if (!isctx) { b = r >> 13; t = r & 8191; } else { const int rc = r - MLAT; b = rc >> 8; t = rc & 255; }
                const int c = cb + cl, h = c >> 7, e = c & 127;
                const int ku = isctx ? ((b * 4 + h) * 33 + 32) : ((b * 4 + h) * 33 + (t >> 8)); const int mm = isctx ? t : (t & 255);
                const bool odd = fr & 1; unsigned pv[4]; pair_pack(lo, hi, odd, pv);
                bf16_t* dst = BTU + ((size_t)ku * 128 + e + (odd ? 4 : 0)) * 512 + (mm & ~1);
#pragma unroll
                for (int i = 0; i < 4; ++i) *(unsigned*)(dst + i * 512) = pv[i];
            EPI_LOOP_END
        } else {
            EPI_LOOP_BEGIN
                *(u32x4*)(GB + (size_t)(u.pm * 256 + rl) * 512 + cb + cl) = pk8(lo, hi);
            EPI_LOOP_END
        }
    }
};
struct EpiS {
    static constexpr bool AFTER_DRAIN = false;
    bf16_t* A2U; const float* ldf; const float* ldb;
    __device__ __forceinline__ void operator()(const f32x4 (&acc)[2][2][4][2], const Unit& u, int wr, int wc, int fr, int fq) const {
        const float lf = ldf[u.pn], nlb = -ldb[u.pn];
        EPI_LOOP_BEGIN
            const float dd = (float)(rl - cl), rt = -lf * (float)(rl + 1);
#pragma unroll
            for (int i = 0; i < 4; ++i) {
                const float d0 = dd - (float)i, d1 = dd - (float)(4 + i);
                lo[i] *= __expf(fminf(lf * d0, nlb * d0) + rt);
                hi[i] *= __expf(fminf(lf * d1, nlb * d1) + rt);
            }
            *(u32x4*)(A2U + ((size_t)u.pm * 256 + rl) * 512 + cl) = pk8(lo, hi);
        EPI_LOOP_END
    }
};
struct EpiKV {
    static constexpr bool AFTER_DRAIN = false;
    bf16_t* KVT;
    __device__ __forceinline__ void operator()(const f32x4 (&acc)[2][2][4][2], const Unit& u, int wr, int wc, int fr, int fq) const {
        EPI_LOOP_BEGIN
            if (ai == 0) *(u32x4*)(KVT + ((size_t)u.pm * 128 + rl) * 256 + cl) = pk8(lo, hi);
        EPI_LOOP_END
    }
};
struct EpiE {
    static constexpr bool AFTER_DRAIN = false;
    bf16_t* SST;
    __device__ __forceinline__ void operator()(const f32x4 (&acc)[2][2][4][2], const Unit& u, int wr, int wc, int fr, int fq) const {
        EPI_LOOP_BEGIN
            if (u.pm * 256 + rl < 1056) *(u32x4*)(SST + ((size_t)(u.pn * 1280 + u.pm * 256 + rl)) * 256 + cl) = pk8(lo, hi);
        EPI_LOOP_END
    }
};
struct EpiOLn {
    static constexpr bool AFTER_DRAIN = false;
    const bf16_t* GB; bf16_t* MIX; LAS f32x2* T;
    __device__ __forceinline__ void operator()(const f32x4 (&acc)[2][2][4][2], const Unit& u, int wr, int wc, int fr, int fq) const {
        const int bh = u.pm >> 5, cc = u.pm & 31, b = bh >> 2, h = bh & 3, cx = wc * 32 + 8 * fq;
#pragma unroll
        for (int ai = 0; ai < 2; ++ai)
#pragma unroll
            for (int m = 0; m < 4; ++m) { const f32x4 lo = acc[ai][0][m][0], hi = acc[ai][0][m][1];
                float sm = (lo[0] + lo[1]) + (lo[2] + lo[3]) + (hi[0] + hi[1]) + (hi[2] + hi[3]);
                float sq = (lo[0] * lo[0] + lo[1] * lo[1]) + (lo[2] * lo[2] + lo[3] * lo[3]) + (hi[0] * hi[0] + hi[1] * hi[1]) + (hi[2] * hi[2] + hi[3] * hi[3]);
                sm += __shfl_xor(sm, 16); sm += __shfl_xor(sm, 32); sq += __shfl_xor(sq, 16); sq += __shfl_xor(sq, 32);
                if (fq == 0) T[(ai * 128 + wr * 64 + m * 16 + fr) * 4 + wc] = (f32x2){sm, sq}; }
        asm volatile("s_waitcnt lgkmcnt(0)" ::: "memory"); __builtin_amdgcn_s_barrier(); asm volatile("" ::: "memory");
#pragma unroll
        for (int ai = 0; ai < 2; ++ai)
#pragma unroll
            for (int m = 0; m < 4; ++m) { const int rl = ai * 128 + wr * 64 + m * 16 + fr;
                const f32x4 t01 = *(const LAS f32x4*)(T + rl * 4), t23 = *(const LAS f32x4*)(T + rl * 4 + 2);
                const float S1 = (t01[0] + t01[2]) + (t23[0] + t23[2]), S2 = (t01[1] + t01[3]) + (t23[1] + t23[3]);
                const float mu = S1 * (1.0f / 128.0f), var = fmaxf(S2 * (1.0f / 128.0f) - mu * mu, 0.0f), rs = __builtin_amdgcn_rsqf(var + EPS);
                const size_t row = (size_t)(b * SEQ + cc * 256 + rl);
                f32x4 g0, g1; unpk8(*(const u32x4*)(GB + row * 512 + h * 128 + cx), g0, g1);
                f32x4 y0 = (acc[ai][0][m][0] - mu) * rs, y1 = (acc[ai][0][m][1] - mu) * rs;
#pragma unroll
                for (int i = 0; i < 4; ++i) { y0[i] *= silu_(g0[i]); y1[i] *= silu_(g1[i]); }
                *(u32x4*)(MIX + row * 1024 + 512 + h * 128 + cx) = pk8(y0, y1);
                __builtin_amdgcn_sched_barrier(0); }
    }
};
struct EpiY {
    static constexpr bool AFTER_DRAIN = false;
    const bf16_t* US; bf16_t* YG; const float* s5d;
    __device__ __forceinline__ void operator()(const f32x4 (&acc)[2][2][4][2], const Unit& u, int wr, int wc, int fr, int fq) const {
        const int g = u.pn;
        EPI_LOOP_BEGIN
            const int cr = u.pm * 256 + rl, b = cr >> 9, cc = cr & 511, t = cl >> 4, p0 = cl & 15;
            const u32x4 uw = *(const u32x4*)(US + ((size_t)(g * 1280 + cr) * 512 + cl));
            f32x4 ul, uh; unpk8(uw, ul, uh);
            const f32x4 d0 = *(const f32x4*)(s5d + g * 16 + p0), d1 = *(const f32x4*)(s5d + g * 16 + p0 + 4);
            lo = lo + d0 * ul; hi = hi + d1 * uh;
#pragma unroll
            for (int i = 0; i < 1; ++i) { lo = gelu_tanh4(lo); hi = gelu_tanh4(hi); }
            *(u32x4*)(YG + ((size_t)(b * SEQ + cc * 16 + t)) * 512 + g * 16 + p0) = pk8(lo, hi);
        EPI_LOOP_END
    }
};
struct EpiP3 { static constexpr bool AFTER_DRAIN = false; EpiS s; EpiKV kv; EpiE e;
    __device__ __forceinline__ void operator()(const f32x4 (&acc)[2][2][4][2], const Unit& u, int wr, int wc, int fr, int fq) const { if (u.ty == 0) s(acc, u, wr, wc, fr, fq); else if (u.ty == 1) kv(acc, u, wr, wc, fr, fq); else e(acc, u, wr, wc, fr, fq); } };
struct EpiGlu {
    static constexpr bool AFTER_DRAIN = false;
    const bf16_t* YG; bf16_t* MIX; const float* bglu;
    __device__ __forceinline__ void operator()(const f32x4 (&acc)[2][2][4][2], const Unit& u, int wr, int wc, int fr, int fq) const {
        EPI_LOOP_BEGIN
            const int r = u.pm * 256 + rl, c = u.pn * 256 + cl;
            const u32x4 yw = *(const u32x4*)(YG + (size_t)r * 512 + c); f32x4 yl, yh; unpk8(yw, yl, yh);
            const f32x4 b0 = *(const f32x4*)(bglu + c), b1 = *(const f32x4*)(bglu + c + 4);
            lo = lo + b0; hi = hi + b1;
#pragma unroll
            for (int i = 0; i < 4; ++i) { lo[i] = yl[i] * sigmoidf_(lo[i]); hi[i] = yh[i] * sigmoidf_(hi[i]); }
            *(u32x4*)(MIX + (size_t)r * 1024 + c) = pk8(lo, hi);
        EPI_LOOP_END
    }
};
struct EpiRes {
    static constexpr bool AFTER_DRAIN = false;
    const float* base; float* out; const float* gate;
    __device__ __forceinline__ void operator()(const f32x4 (&acc)[2][2][4][2], const Unit& u, int wr, int wc, int fr, int fq) const {
        EPI_LOOP_BEGIN
            const int r = u.pm * 256 + rl, c = u.pn * 256 + cl, b = r >> 13;
            const float* gp = gate + b * 6144 + c; const f32x4 g0 = *(const f32x4*)gp, g1 = *(const f32x4*)(gp + 4);
            const float* bp = base + (size_t)r * 1024 + c; const f32x4 x0 = *(const f32x4*)bp, x1 = *(const f32x4*)(bp + 4);
            float* op = out + (size_t)r * 1024 + c; *(f32x4*)op = x0 + g0 * lo; *(f32x4*)(op + 4) = x1 + g1 * hi;
        EPI_LOOP_END
    }
};
struct EpiUp {
    static constexpr bool AFTER_DRAIN = false;
    bf16_t* H;
    __device__ __forceinline__ void operator()(const f32x4 (&acc)[2][2][4][2], const Unit& u, int wr, int wc, int fr, int fq) const {
        EPI_LOOP_BEGIN
            *(u32x4*)(H + (size_t)(u.pm * 256 + rl) * DFF2 + u.pn * 256 + cl) = pk8(lo, hi);
        EPI_LOOP_END
    }
};


struct SchedUp {
    int G, c; const char* A; const char* B;
    __device__ __forceinline__ bool next(int i, Unit& u) const {
        constexpr int nM = 66, nN = 22, nwg = nM * nN;
        const int L = i * G + c; if (L >= nwg) return false;
        int wgid = L; { const int q = nwg / NXCD, r = nwg % NXCD, xcd = wgid % NXCD, off = wgid / NXCD; wgid = (xcd < r ? xcd * (q + 1) : r * (q + 1) + (xcd - r) * q) + off; }
        const int nig = WGM * nN, gid = wgid / nig, fm = gid * WGM, gsz = (nM - fm) < WGM ? (nM - fm) : WGM;
        u.pm = fm + ((wgid % nig) % gsz); u.pn = (wgid % nig) / gsz;
        const int b = u.pm / 33, j = u.pm - b * 33; int st = 254 * j - 1; st = st < 0 ? 0 : (st > 7936 ? 7936 : st);
        u.a = A + ((size_t)(b * SEQ + st)) * 1024 * 2; u.b = B + (size_t)u.pn * 256 * 1024 * 2; return true;
    }
};
__device__ __forceinline__ float dpp_ror1(float v) { return __int_as_float(__builtin_amdgcn_update_dpp(0, __float_as_int(v), 0x121, 0xf, 0xf, false)); }
__device__ __forceinline__ float dpp_ror15(float v) { return __int_as_float(__builtin_amdgcn_update_dpp(0, __float_as_int(v), 0x12F, 0xf, 0xf, false)); }
__device__ __forceinline__ f32x4 ror1_4(f32x4 v) { f32x4 r; r[0] = dpp_ror1(v[0]); r[1] = dpp_ror1(v[1]); r[2] = dpp_ror1(v[2]); r[3] = dpp_ror1(v[3]); return r; }
__device__ __forceinline__ f32x4 rol1_4(f32x4 v) { f32x4 r; r[0] = dpp_ror15(v[0]); r[1] = dpp_ror15(v[1]); r[2] = dpp_ror15(v[2]); r[3] = dpp_ror15(v[3]); return r; }
struct EpiUpConv {
    static constexpr bool AFTER_DRAIN = false;
    bf16_t* HH; const float* cw; const float* cbias; LAS float* X;
    __device__ __forceinline__ void operator()(const f32x4 (&acc)[2][2][4][2], const Unit& u, int wr, int wc, int fr, int fq) const {
        const int b = u.pm / 33, j = u.pm - b * 33; int st = 254 * j - 1; st = st < 0 ? 0 : (st > 7936 ? 7936 : st);
        const int cx = wc * 32 + 8 * fq, F = u.pn * 128 + cx;
        const f32x4 w0l = *(const f32x4*)(cw + F), w0h = *(const f32x4*)(cw + F + 4), w1l = *(const f32x4*)(cw + DFF + F), w1h = *(const f32x4*)(cw + DFF + F + 4),
                    w2l = *(const f32x4*)(cw + 2 * DFF + F), w2h = *(const f32x4*)(cw + 2 * DFF + F + 4), bl = *(const f32x4*)(cbias + F), bh = *(const f32x4*)(cbias + F + 4);
#pragma unroll
        for (int ai = 0; ai < 2; ++ai) { const int blk = ai * 2 + wr;
            if (fr == 0) { LAS float* d = X + (blk * 2 + 0) * 128 + cx; *(LAS f32x4*)d = acc[ai][1][0][0]; *(LAS f32x4*)(d + 4) = acc[ai][1][0][1]; }
            if (fr == 15) { LAS float* d = X + (blk * 2 + 1) * 128 + cx; *(LAS f32x4*)d = acc[ai][1][3][0]; *(LAS f32x4*)(d + 4) = acc[ai][1][3][1]; } }
        asm volatile("s_waitcnt lgkmcnt(0)" ::: "memory"); __builtin_amdgcn_s_barrier(); asm volatile("" ::: "memory");
        const f32x4 z4 = (f32x4){0.f, 0.f, 0.f, 0.f};
#pragma unroll
        for (int ai = 0; ai < 2; ++ai) { const int blk = ai * 2 + wr;
            f32x4 xpl = z4, xph = z4, xnl = z4, xnh = z4;
            if (blk > 0) { const LAS float* q = X + ((blk - 1) * 2 + 1) * 128 + cx; xpl = *(const LAS f32x4*)q; xph = *(const LAS f32x4*)(q + 4); }
            if (blk < 3) { const LAS float* q = X + ((blk + 1) * 2 + 0) * 128 + cx; xnl = *(const LAS f32x4*)q; xnh = *(const LAS f32x4*)(q + 4); }
            f32x4 rpl = xpl, rph = xph;
            f32x4 cnl = rol1_4(acc[ai][1][0][0]), cnh = rol1_4(acc[ai][1][0][1]);
#pragma unroll
            for (int m = 0; m < 4; ++m) {
                const f32x4 gl = acc[ai][1][m][0], gh = acc[ai][1][m][1];
                const f32x4 rl_ = ror1_4(gl), rh_ = ror1_4(gh);
                f32x4 pl = rl_, ph = rh_, nl = cnl, nh = cnh, enl, enh;
                if (m < 3) { enl = rol1_4(acc[ai][1][m < 3 ? m + 1 : 3][0]); enh = rol1_4(acc[ai][1][m < 3 ? m + 1 : 3][1]); } else { enl = xnl; enh = xnh; }
                if (fr == 0) { pl = rpl; ph = rph; }
                if (fr == 15) { nl = enl; nh = enh; }
                rpl = rl_; rph = rh_; cnl = enl; cnh = enh;
                f32x4 ol = bl + pl * w0l + gl * w1l + nl * w2l, oh = bh + ph * w0h + gh * w1h + nh * w2h;
                const f32x4 al = acc[ai][0][m][0], ah = acc[ai][0][m][1];
#pragma unroll
                for (int i = 0; i < 1; ++i) { ol = gelu_tanh4(ol) * al; oh = gelu_tanh4(oh) * ah; }
                const int rl = ai * 128 + wr * 64 + m * 16 + fr, t = st + rl;
                if ((rl >= 1 || t == 0) && (rl <= 254 || t == SEQ - 1))
                    *(u32x4*)(HH + ((size_t)(b * SEQ + t)) * DFF + F) = pk8(ol, oh);
                __builtin_amdgcn_sched_barrier(0);
            }
        }
    }
};

struct RowSq {
    unsigned* xbuf; unsigned* cnt;
    __device__ __forceinline__ void run(const f32x4 (&v)[2][2][4][2], const Unit& u, int wr, int wc, int fr, int fq, LAS unsigned char* lds, int wid, int lane) const {
        LAS float* P = (LAS float*)lds; LAS float* S = (LAS float*)(lds + 4096);
#pragma unroll
        for (int ai = 0; ai < 2; ++ai)
#pragma unroll
            for (int m = 0; m < 4; ++m) {
                float s = 0.f;
#pragma unroll
                for (int bj = 0; bj < 2; ++bj)
#pragma unroll
                    for (int n = 0; n < 2; ++n) { const f32x4 x = v[ai][bj][m][n]; s += (x[0] * x[0] + x[1] * x[1]) + (x[2] * x[2] + x[3] * x[3]); }
                s += __shfl_xor(s, 16); s += __shfl_xor(s, 32);
                if (fq == 0) P[(ai * 128 + wr * 64 + m * 16 + fr) * 4 + wc] = s;
            }
        asm volatile("s_waitcnt lgkmcnt(0)" ::: "memory"); __builtin_amdgcn_s_barrier(); asm volatile("" ::: "memory");
        const int row = wid * 32 + (lane & 31);
        if (lane < 32) { const float t = (P[row * 4 + 0] + P[row * 4 + 1]) + (P[row * 4 + 2] + P[row * 4 + 3]);
            __hip_atomic_store(xbuf + ((size_t)(u.pm * 256 + row) * 4 + u.pn), __float_as_uint(t), __ATOMIC_RELAXED, __HIP_MEMORY_SCOPE_AGENT); }
        asm volatile("s_waitcnt vmcnt(0)" ::: "memory");
        if (lane == 0) __hip_atomic_fetch_add(cnt + 64 * u.pm, 1u, __ATOMIC_RELAXED, __HIP_MEMORY_SCOPE_AGENT);
        if (wid == 0) {
            unsigned sp = 0;
            while ((unsigned)__builtin_amdgcn_readfirstlane(__hip_atomic_load(cnt + 64 * u.pm, __ATOMIC_RELAXED, __HIP_MEMORY_SCOPE_AGENT)) < 32u) { __builtin_amdgcn_s_sleep(2); if (++sp > (1u << 22)) break; }
            __builtin_amdgcn_fence(__ATOMIC_ACQUIRE, "agent");
        }
        asm volatile("s_waitcnt vmcnt(0) lgkmcnt(0)" ::: "memory"); __builtin_amdgcn_s_barrier(); asm volatile("" ::: "memory");
        if (lane < 32) { unsigned* slot = xbuf + (size_t)(u.pm * 256 + row) * 4; float t = 0.f;
#pragma unroll
            for (int q = 0; q < 4; ++q) t += __uint_as_float(__hip_atomic_load(slot + q, __ATOMIC_RELAXED, __HIP_MEMORY_SCOPE_AGENT));
            S[row] = 1.0f / sqrtf(t * (1.0f / 1024.0f) + EPS); }
        asm volatile("s_waitcnt lgkmcnt(0)" ::: "memory"); __builtin_amdgcn_s_barrier(); asm volatile("" ::: "memory");
    }
};
struct EpiOutNorm {
    static constexpr bool AFTER_DRAIN = true;
    const float* x; bf16_t* X1B; bf16_t* XN; const float* MOD; const float* w; RowSq st;
    __device__ __forceinline__ void fused(f32x4 (&acc)[2][2][4][2], const Unit& u, int wr, int wc, int fr, int fq, LAS unsigned char* lds, int wid, int lane) const {
        f32x4 xa[2][2][2], xb[2][2][2];
#define LOADB(dst, am) do { const int ai_ = (am) >> 1, m0_ = ((am) & 1) * 2; _Pragma("unroll") for (int mm = 0; mm < 2; ++mm) { const int r_ = u.pm * 256 + ai_ * 128 + wr * 64 + (m0_ + mm) * 16 + fr; \
            _Pragma("unroll") for (int bj = 0; bj < 2; ++bj) { const float* bp = x + (size_t)r_ * 1024 + u.pn * 256 + bj * 128 + wc * 32 + 8 * fq; dst[mm][bj][0] = *(const f32x4*)bp; dst[mm][bj][1] = *(const f32x4*)(bp + 4); } } } while (0)
#define USEB(src, am) do { const int ai = (am) >> 1, m0_ = ((am) & 1) * 2; _Pragma("unroll") for (int mm = 0; mm < 2; ++mm) { const int m = m0_ + mm; const int r = u.pm * 256 + ai * 128 + wr * 64 + m * 16 + fr, b = r >> 13; \
            _Pragma("unroll") for (int bj = 0; bj < 2; ++bj) { const int c = u.pn * 256 + bj * 128 + wc * 32 + 8 * fq; \
                const float* gp = MOD + b * 6144 + 2048 + c; const f32x4 g0 = *(const f32x4*)gp, g1 = *(const f32x4*)(gp + 4); \
                const f32x4 y0 = src[mm][bj][0] + g0 * acc[ai][bj][m][0], y1 = src[mm][bj][1] + g1 * acc[ai][bj][m][1]; \
                acc[ai][bj][m][0] = y0; acc[ai][bj][m][1] = y1; \
                *(u32x4*)(X1B + (size_t)r * 1024 + c) = pk8(y0, y1); } } asm volatile("" ::: "memory"); } while (0)
        LOADB(xa, 0); LOADB(xb, 1); USEB(xa, 0); LOADB(xa, 2); USEB(xb, 1); LOADB(xb, 3); USEB(xa, 2); USEB(xb, 3);
#undef LOADB
#undef USEB
        __builtin_amdgcn_sched_barrier(0);
        st.run(acc, u, wr, wc, fr, fq, lds, wid, lane);
        const LAS float* S = (const LAS float*)(lds + 4096);
#pragma unroll
        for (int ai = 0; ai < 2; ++ai)
#pragma unroll
            for (int m = 0; m < 4; ++m) { const int rl = ai * 128 + wr * 64 + m * 16 + fr, r = u.pm * 256 + rl, b = r >> 13; const float rs = S[rl];
#pragma unroll
                for (int bj = 0; bj < 2; ++bj) { const int c = u.pn * 256 + bj * 128 + wc * 32 + 8 * fq;
                    const float* mp = MOD + b * 6144 + c;
                    const f32x4 sh0 = *(const f32x4*)(mp + 3072), sh1 = *(const f32x4*)(mp + 3076), sc0 = *(const f32x4*)(mp + 4096), sc1 = *(const f32x4*)(mp + 4100);
                    const f32x4 w0 = *(const f32x4*)(w + c), w1 = *(const f32x4*)(w + c + 4);
                    const f32x4 y0 = acc[ai][bj][m][0] * rs * w0 * (sc0 + 1.0f) + sh0, y1 = acc[ai][bj][m][1] * rs * w1 * (sc1 + 1.0f) + sh1;
                    *(u32x4*)(XN + (size_t)r * 1024 + c) = pk8(y0, y1); }
                asm volatile("" ::: "memory"); __builtin_amdgcn_sched_barrier(0); }
    }
};
struct EpiDownNorm {
    static constexpr bool AFTER_DRAIN = true;
    const bf16_t* X1B; float* out; const float* MOD; const float* w; RowSq st;
    __device__ __forceinline__ void fused(f32x4 (&acc)[2][2][4][2], const Unit& u, int wr, int wc, int fr, int fq, LAS unsigned char* lds, int wid, int lane) const {
        u32x4 xs[2][4][2];
#pragma unroll
        for (int ai = 0; ai < 2; ++ai)
#pragma unroll
            for (int m = 0; m < 4; ++m) { const int r = u.pm * 256 + ai * 128 + wr * 64 + m * 16 + fr;
#pragma unroll
                for (int bj = 0; bj < 2; ++bj) xs[ai][m][bj] = *(const u32x4*)(X1B + (size_t)r * 1024 + u.pn * 256 + bj * 128 + wc * 32 + 8 * fq); }
#pragma unroll
        for (int ai = 0; ai < 2; ++ai) {
#pragma unroll
            for (int m = 0; m < 4; ++m) { const int r = u.pm * 256 + ai * 128 + wr * 64 + m * 16 + fr, b = r >> 13;
#pragma unroll
                for (int bj = 0; bj < 2; ++bj) { const int c = u.pn * 256 + bj * 128 + wc * 32 + 8 * fq;
                    const float* gp = MOD + b * 6144 + 5120 + c; const f32x4 g0 = *(const f32x4*)gp, g1 = *(const f32x4*)(gp + 4);
                    f32x4 x0, x1; unpk8(xs[ai][m][bj], x0, x1);
                    acc[ai][bj][m][0] = x0 + g0 * acc[ai][bj][m][0]; acc[ai][bj][m][1] = x1 + g1 * acc[ai][bj][m][1]; }
                asm volatile("" : "+v"(acc[ai][0][m][0]), "+v"(acc[ai][0][m][1]), "+v"(acc[ai][1][m][0]), "+v"(acc[ai][1][m][1]));
            } }
        asm volatile("" ::: "memory"); __builtin_amdgcn_sched_barrier(0);
        st.run(acc, u, wr, wc, fr, fq, lds, wid, lane);
        const LAS float* S = (const LAS float*)(lds + 4096);
#pragma unroll
        for (int ai = 0; ai < 2; ++ai)
#pragma unroll
            for (int m = 0; m < 4; ++m) { const int rl = ai * 128 + wr * 64 + m * 16 + fr, r = u.pm * 256 + rl; const float rs = S[rl];
#pragma unroll
                for (int bj = 0; bj < 2; ++bj) { const int c = u.pn * 256 + bj * 128 + wc * 32 + 8 * fq;
                    const f32x4 w0 = *(const f32x4*)(w + c), w1 = *(const f32x4*)(w + c + 4);
                    float* op = out + (size_t)r * 1024 + c; *(f32x4*)op = acc[ai][bj][m][0] * rs * w0; *(f32x4*)(op + 4) = acc[ai][bj][m][1] * rs * w1; }
                asm volatile("" ::: "memory"); __builtin_amdgcn_sched_barrier(0); }
    }
};

template <bool UPMAP = false>
__device__ __forceinline__ void transpose_item(const float* W, int K, int N, bf16_t* WT, LAS float* scr, int item, int lane) {
    const int nblk = N / 32, kb = item / nblk, nb = item % nblk, k0 = 64 * kb, n0 = 32 * nb;
    const int d0 = !UPMAP ? n0 : (n0 < DFF ? 256 * (n0 >> 7) + (n0 & 127) : 256 * ((n0 - DFF) >> 7) + 128 + ((n0 - DFF) & 127));
    { f32x4 v[8]; const int kr = lane >> 3, c4 = (lane & 7) * 4;
#pragma unroll
      for (int i = 0; i < 8; ++i) v[i] = *(const f32x4*)(W + (size_t)(k0 + i * 8 + kr) * N + n0 + c4);
#pragma unroll
      for (int i = 0; i < 8; ++i) { LAS float* d = scr + (i * 8 + kr) * 33 + c4; d[0] = v[i][0]; d[1] = v[i][1]; d[2] = v[i][2]; d[3] = v[i][3]; } }
    asm volatile("s_waitcnt lgkmcnt(0)" ::: "memory");
    const int c = lane & 7;
#pragma unroll
    for (int j = 0; j < 4; ++j) { const int n = (lane >> 3) + 8 * j; const LAS float* s = scr + (8 * c) * 33 + n;
        u32x4 o; o.x = cvt_pk_bf16(s[0 * 33], s[1 * 33]); o.y = cvt_pk_bf16(s[2 * 33], s[3 * 33]); o.z = cvt_pk_bf16(s[4 * 33], s[5 * 33]); o.w = cvt_pk_bf16(s[6 * 33], s[7 * 33]);
        *(u32x4*)(WT + (size_t)(d0 + n) * K + k0 + 8 * c) = o; }
    asm volatile("s_waitcnt lgkmcnt(0)" ::: "memory");
}

__device__ __forceinline__ void norm_rows2_bf16(const float* xa, const float* xb, const float* w, const LAS float* sha, const LAS float* sca, const LAS float* shb, const LAS float* scb, bf16_t* oa, bf16_t* ob, int lane) {
    const f32x4* pa = (const f32x4*)xa + lane; const f32x4* pb = (const f32x4*)xb + lane;
    f32x4 va[4], vb[4]; float s0 = 0.f, s1 = 0.f;
#pragma unroll
    for (int j = 0; j < 4; ++j) { va[j] = pa[64 * j]; vb[j] = pb[64 * j]; }
#pragma unroll
    for (int j = 0; j < 4; ++j) { s0 += (va[j][0] * va[j][0] + va[j][1] * va[j][1]) + (va[j][2] * va[j][2] + va[j][3] * va[j][3]); s1 += (vb[j][0] * vb[j][0] + vb[j][1] * vb[j][1]) + (vb[j][2] * vb[j][2] + vb[j][3] * vb[j][3]); }
    const float ra = 1.0f / sqrtf(wave_sum(s0) * (1.0f / 1024.0f) + EPS), rb = 1.0f / sqrtf(wave_sum(s1) * (1.0f / 1024.0f) + EPS);
#pragma unroll
    for (int j = 0; j < 4; ++j) {
        const int c = 4 * (lane + 64 * j);
        const f32x4 ww = *(const f32x4*)(w + c);
        const f32x4 ya = va[j] * ra * ww * (*(const LAS f32x4*)(sca + c) + 1.0f) + *(const LAS f32x4*)(sha + c);
        const f32x4 yb = vb[j] * rb * ww * (*(const LAS f32x4*)(scb + c) + 1.0f) + *(const LAS f32x4*)(shb + c);
        u32x2 o; o.x = cvt_pk_bf16(ya[0], ya[1]); o.y = cvt_pk_bf16(ya[2], ya[3]); *(u32x2*)(oa + c) = o;
        o.x = cvt_pk_bf16(yb[0], yb[1]); o.y = cvt_pk_bf16(yb[2], yb[3]); *(u32x2*)(ob + c) = o;
    }
}

constexpr int LDS_BYTES = STAGE_BYTES + 12288;
#define PHASE_IDS int tid_p = threadIdx.x; asm volatile("" : "+v"(tid_p)); const int tid = tid_p, lane = tid & 63, wave = __builtin_amdgcn_readfirstlane(tid >> 6), gw = bx * 8 + wave; (void)lane; (void)gw; (void)tid;

__global__ void __launch_bounds__(512, 2) fwd_kernel(Params p) {
    extern __shared__ __attribute__((aligned(16))) unsigned char lds_raw[];
    LAS unsigned char* lds = (LAS unsigned char*)lds_raw;
    cg::grid_group grid = cg::this_grid();
    { volatile LAS unsigned* st0 = (volatile LAS unsigned*)(lds + STAGE_BYTES); if (threadIdx.x < 4) st0[threadIdx.x] = 0u; }
    __syncthreads();
    const XcdBarrier xbar = xcd_barrier_post((unsigned*)(p.ws + WS_BAR), (volatile LAS unsigned*)(lds + STAGE_BYTES));
    if (p.ws == nullptr) grid.sync();
#define GRID_BAR() xcd_barrier(xbar)
    const int G = gridDim.x, bx = blockIdx.x, NGW = G * 8;
    unsigned char* ws = p.ws;
    const float* x = p.in[0]; const float* cvec = p.in[1]; const float* ctx = p.in[2]; const float* cctx = p.in[3];
    const float* w_mod = p.in[4]; const float* b_mod = p.in[5];
    bf16_t* WIN = (bf16_t*)(ws + WS_WIN); bf16_t* WGLU = (bf16_t*)(ws + WS_WGLU); bf16_t* WOUT = (bf16_t*)(ws + WS_WOUT);
    bf16_t* S5E = (bf16_t*)(ws + WS_S5E); bf16_t* S5WY = (bf16_t*)(ws + WS_S5WY);
    float* KT = (float*)(ws + WS_KT); unsigned* XCH = (unsigned*)(ws + WS_XCH); unsigned* CNT = (unsigned*)(ws + WS_CNT);
    float* MODP = (float*)(ws + WS_MODP); float* MOD = (float*)(ws + WS_MOD); f32x2* ROPE = (f32x2*)(ws + WS_ROPE); f32x2* L16 = (f32x2*)(ws + WS_L16);
    bf16_t* WUP = (bf16_t*)(ws + WS_WUP); bf16_t* WDOWN = (bf16_t*)(ws + WS_WDOWN);
    bf16_t* XN = (bf16_t*)(ws + WS_XN); bf16_t* KVT = (bf16_t*)(ws + WS_KVT); bf16_t* YG = (bf16_t*)(ws + WS_XN);
    bf16_t* US = (bf16_t*)(ws + WS_US); bf16_t* QB = (bf16_t*)(ws + WS_QB); bf16_t* KB = (bf16_t*)(ws + WS_KB); bf16_t* GB = (bf16_t*)(ws + WS_GB);
    bf16_t* KW = (bf16_t*)(ws + WS_KW); bf16_t* X1B = (bf16_t*)(ws + WS_KW);
    bf16_t* BTU = (bf16_t*)(ws + WS_BTU);
    bf16_t* SST = (bf16_t*)(ws + WS_SST); bf16_t* MIX = (bf16_t*)(ws + WS_SST); bf16_t* HAG = (bf16_t*)(ws + WS_HAG);
    bf16_t* A2U = (bf16_t*)p.out;
    const float* ldf = p.in[21]; const float* ldb = p.in[22];

    for (int rep_ = 0; rep_ < (((REPM >> 0) & 1) ? 2 : 1); ++rep_) { if constexpr ((PM >> 0) & 1) {
        PHASE_IDS
        LAS float* scr = (LAS float*)(lds + wave * 16384);
        constexpr int I_IN = 16 * 80, I_GLU = 8 * 16, I_OUT = 16 * 32, I_T = I_IN + I_GLU + I_OUT, I_ALL = I_T + 768;
        for (int it = gw; it < I_ALL; it += NGW) {
            int r = it;
            if (r < I_IN) { transpose_item(p.in[7], 1024, INC, WIN, scr, r, lane); continue; } r -= I_IN;
            if (r < I_GLU) { transpose_item(p.in[19], 512, 512, WGLU, scr, r, lane); continue; } r -= I_GLU;
            if (r < I_OUT) { transpose_item(p.in[23], 1024, 1024, WOUT, scr, r, lane); continue; } r -= I_OUT;
            const int cgp = r >> 3, kc = r & 7, col = cgp * 64 + lane;
            float sv[3][2];
#pragma unroll
            for (int hh = 0; hh < 2; ++hh) { const int k = kc * 128 + hh * 64 + lane; sv[0][hh] = silu_(cvec[k]); sv[1][hh] = silu_(cvec[1024 + k]); sv[2][hh] = silu_(cctx[k]); }
            float a0 = 0.f, a1 = 0.f, a2 = 0.f;
            const float* wp = w_mod + (size_t)(kc * 128) * 6144 + col;
#pragma unroll
            for (int hh = 0; hh < 2; ++hh) {
                float wv[64];
#pragma unroll
                for (int kk = 0; kk < 64; ++kk) wv[kk] = wp[(size_t)(hh * 64 + kk) * 6144];
#pragma unroll
                for (int kk = 0; kk < 64; ++kk) { a0 += __shfl(sv[0][hh], kk) * wv[kk]; a1 += __shfl(sv[1][hh], kk) * wv[kk]; a2 += __shfl(sv[2][hh], kk) * wv[kk]; }
            }
            MODP[(kc * 3 + 0) * 6144 + col] = a0; MODP[(kc * 3 + 1) * 6144 + col] = a1; MODP[(kc * 3 + 2) * 6144 + col] = a2;
        }
        for (int idx = bx * 512 + tid; idx < 4096; idx += G * 512) { const int pos = idx >> 5, j = idx & 31; const float invf = exp2f(-(float)j * (13.287712379549449f / 32.0f)); float s, c; sincos_red((float)pos * invf, s, c); ROPE[idx] = (f32x2){c, s}; }
        __syncthreads();
        for (int vj = bx; vj < 256; vj += G) {
            const int g = vj >> 3, sub = vj & 7;
            LAS f32x2* Lp = (LAS f32x2*)lds;
            LAS f32x2* bbar = (LAS f32x2*)(lds + 17408);
            LAS f32x2* Cc = (LAS f32x2*)(lds + 17408 + 16384);
            LAS f32x2* coef = (LAS f32x2*)(lds + 17408 + 16384 + 8192);
            __syncthreads();
            if (tid < 128) {
                const int d = tid >> 6, n = tid & 63;
                const float lr = p.in[d ? 11 : 8][g * 64 + n], li = p.in[d ? 12 : 9][g * 64 + n], step = expf(p.in[d ? 13 : 10][g]);
                const float mag = expf(lr * step); float sn, cs; sincos_red(li * step, sn, cs);
                const float br = mag * cs, bi = mag * sn;
                float pr = 1.f, pi = 0.f;
#pragma unroll 1
                for (int tau = 0; tau <= 16; ++tau) { Lp[(d * 17 + tau) * 64 + n] = (f32x2){pr, pi}; const float nr = pr * br - pi * bi, ni = pr * bi + pi * br; pr = nr; pi = ni; }
                const float nr_ = br - 1.0f, ni_ = bi, den = lr * lr + li * li;
                coef[d * 64 + n] = (f32x2){(nr_ * lr + ni_ * li) / den, (ni_ * lr - nr_ * li) / den};
            }
            __syncthreads();
            if (sub == 0 && tid < 128) L16[g * 128 + tid] = Lp[((tid >> 6) * 17 + 16) * 64 + (tid & 63)];
            for (int idx = tid; idx < 2048; idx += 512) { const int d = idx >> 10, n = (idx >> 4) & 63, pp = idx & 15;
                const float bre = p.in[14][(g * 64 + n) * 16 + pp], bim = p.in[15][(g * 64 + n) * 16 + pp]; const f32x2 cf = coef[d * 64 + n];
                bbar[idx] = (f32x2){cf[0] * bre - cf[1] * bim, cf[0] * bim + cf[1] * bre}; }
            for (int idx = tid; idx < 1024; idx += 512) Cc[idx] = (f32x2){p.in[16][g * 1024 + idx], p.in[17][g * 1024 + idx]};
            __syncthreads();
            for (int idx = tid; idx < 1024; idx += 512) { const int d = idx >> 9, tau = 2 * sub + ((idx >> 8) & 1), pp = (idx >> 4) & 15, pq = idx & 15;
                float a = 0.f;
#pragma unroll 4
                for (int n = 0; n < 64; ++n) { const f32x2 cz = Cc[pp * 64 + n], lz = Lp[(d * 17 + tau) * 64 + n], bz = bbar[(d * 64 + n) * 16 + pq];
                    const float zr = cz[0] * lz[0] - cz[1] * lz[1], zi = cz[0] * lz[1] + cz[1] * lz[0]; a += zr * bz[0] - zi * bz[1]; }
                KT[((g * 2 + d) * 16 + tau) * 256 + pp * 16 + pq] = a; }
            for (int idx = tid; idx < 1024; idx += 512) { const int row = sub * 32 + (idx >> 5), c8 = (idx & 31) * 8, d = row >> 7, ri = (row >> 6) & 1, n = row & 63, sx = c8 >> 4, q0 = c8 & 15;
                const f32x2 lz = Lp[(d * 17 + (d ? sx : 15 - sx)) * 64 + n]; float o[8];
#pragma unroll
                for (int i = 0; i < 8; ++i) { const f32x2 bz = bbar[(d * 64 + n) * 16 + q0 + i]; o[i] = ri ? (lz[0] * bz[1] + lz[1] * bz[0]) : (lz[0] * bz[0] - lz[1] * bz[1]); }
                u32x4 w; w.x = cvt_pk_bf16(o[0], o[1]); w.y = cvt_pk_bf16(o[2], o[3]); w.z = cvt_pk_bf16(o[4], o[5]); w.w = cvt_pk_bf16(o[6], o[7]);
                *(u32x4*)(S5E + ((size_t)(g * 256 + row) * 256 + c8)) = w; }
            for (int idx = tid; idx < 1024; idx += 512) { const int rowl = idx >> 5, t = 2 * sub + (rowl >> 4), pp = rowl & 15, row = t * 16 + pp, kk = (idx & 31) * 8;
                const int d = kk >> 7, ri = (kk >> 6) & 1, n0 = kk & 63, pw = d ? (16 - t) : (t + 1); float o[8];
#pragma unroll
                for (int i = 0; i < 8; ++i) { const f32x2 cz = Cc[pp * 64 + n0 + i], lz = Lp[(d * 17 + pw) * 64 + n0 + i];
                    o[i] = ri ? -(cz[0] * lz[1] + cz[1] * lz[0]) : (cz[0] * lz[0] - cz[1] * lz[1]); }
                u32x4 w; w.x = cvt_pk_bf16(o[0], o[1]); w.y = cvt_pk_bf16(o[2], o[3]); w.z = cvt_pk_bf16(o[4], o[5]); w.w = cvt_pk_bf16(o[6], o[7]);
                *(u32x4*)(S5WY + ((size_t)(g * 256 + row) * 512 + 256 + kk)) = w; }
            __syncthreads();
        }
    }
    GRID_BAR(); }

    for (int rep_ = 0; rep_ < (((REPM >> 1) & 1) ? 2 : 1); ++rep_) { if constexpr ((PM >> 1) & 1) {
        PHASE_IDS
        LAS float* ms = (LAS float*)lds;
        { float pv[12][8];
#pragma unroll
          for (int k = 0; k < 12; ++k) { const int idx = tid + 512 * k, r = idx >> 11, j = idx & 2047;
#pragma unroll
              for (int q = 0; q < 8; ++q) pv[k][q] = MODP[(q * 3 + r) * 6144 + j]; }
#pragma unroll
          for (int k = 0; k < 12; ++k) { const int idx = tid + 512 * k, j = idx & 2047;
              ms[idx] = b_mod[j] + ((pv[k][0] + pv[k][1]) + (pv[k][2] + pv[k][3])) + ((pv[k][4] + pv[k][5]) + (pv[k][6] + pv[k][7])); } }
        for (int idx = bx * 512 + tid; idx < 3 * 6144; idx += G * 512) { const int r = idx / 6144, j = idx % 6144; float a = b_mod[j];
#pragma unroll
            for (int q = 0; q < 8; ++q) a += MODP[(q * 3 + r) * 6144 + j];
            MOD[idx] = a; }
        __syncthreads();
        for (int rp = gw; rp < MALL / 2; rp += NGW) {
            const int ra = rp, rb = rp + MALL / 2;
            const int ca = ra < SEQ ? 0 : (ra < MLAT ? 1 : 2), cb2 = rb < SEQ ? 0 : (rb < MLAT ? 1 : 2);
            const float* sa = ra < MLAT ? x + (size_t)ra * 1024 : ctx + (size_t)(ra - MLAT) * 1024;
            const float* sb = rb < MLAT ? x + (size_t)rb * 1024 : ctx + (size_t)(rb - MLAT) * 1024;
            norm_rows2_bf16(sa, sb, p.in[6], ms + ca * 2048, ms + ca * 2048 + 1024, ms + cb2 * 2048, ms + cb2 * 2048 + 1024, XN + (size_t)ra * 1024, XN + (size_t)rb * 1024, lane);
        }
        __syncthreads();
    }
    GRID_BAR(); }

    for (int rep_ = 0; rep_ < (((REPM >> 2) & 1) ? 2 : 1); ++rep_) { if constexpr ((PM >> 2) & 1) {
        PHASE_IDS
        SchedIn S{66, 6, 396, G, bx, 0, 2, (const char*)XN, (const char*)WIN, 0, 2 * G - 396, 2};
        EpiIn E{US, QB, KB, GB, KW, BTU, A2U, ROPE, ldf, ldb};
        gemm_phase(lds, 1024, 1024, 1024, S, E);
    }
    GRID_BAR(); }

    for (int rep_ = 0; rep_ < (((REPM >> 3) & 1) ? 2 : 1); ++rep_) { if constexpr ((PM >> 3) & 1) {
        PHASE_IDS
        const int qdone = 2 * G - 396, nA = (128 - qdone) + 128;
        { SchedIn S{64, 2, 0, nA, bx < nA ? bx : -1, 0, 0, (const char*)XN, (const char*)WIN, qdone, 128, 2};
          EpiIn E{US, QB, KB, GB, KW, BTU, A2U, ROPE, ldf, ldb};
          gemm_phase(lds, 1024, 1024, 1024, S, E); }
        { SchedIn S{64, 2, 0, nA, (bx < nA && bx >= 128 - qdone) ? bx - (128 - qdone) : -1, 0, 0, (const char*)XN, (const char*)WIN, 0, 128, 8};
          EpiIn E{US, QB, KB, GB, KW, BTU, A2U, ROPE, ldf, ldb};
          gemm_phase(lds, 1024, 1024, 1024, S, E); }
        { SchedP3 S{G - nA, bx >= nA ? bx - nA : -1, 256, 680, (const char*)QB, (const char*)KB, (const char*)BTU, (const char*)KW, (const char*)US, (const char*)S5E};
          EpiP3 E{EpiS{A2U, ldf, ldb}, EpiKV{KVT}, EpiE{SST}};
          gemm_phase(lds, 512, 256, 256, S, E); }
    }
    GRID_BAR(); }

    for (int rep_ = 0; rep_ < (((REPM >> 4) & 1) ? 2 : 1); ++rep_) { if constexpr ((PM >> 4) & 1) {
        PHASE_IDS
        const int hG = G >> 1;
        if (bx >= hG) for (int idx = (bx - hG) * 512 + tid; idx < 32 * 256 * 32; idx += (G - hG) * 512) { const int g = idx >> 13, row = (idx >> 5) & 255, k8 = (idx & 31) * 8, t = row >> 4, pp = row & 15, sx = k8 >> 4, q0 = k8 & 15;
            const float* kt = KT + (size_t)g * 2 * 16 * 256 + pp * 16 + q0; f32x4 lo, hi;
            if (sx < t) { const float* q = kt + (t - sx) * 256; lo = *(const f32x4*)q; hi = *(const f32x4*)(q + 4); }
            else if (sx > t) { const float* q = kt + (16 + (sx - t)) * 256; lo = *(const f32x4*)q; hi = *(const f32x4*)(q + 4); }
            else { const float* q = kt; const float* q2 = kt + 16 * 256; lo = *(const f32x4*)q + *(const f32x4*)q2; hi = *(const f32x4*)(q + 4) + *(const f32x4*)(q2 + 4); }
            *(u32x4*)(S5WY + ((size_t)(g * 256 + row) * 512 + k8)) = pk8(lo, hi); }
        if (bx >= hG) { LAS float* scr = (LAS float*)(lds + wave * 16384); constexpr int I_UPH = 16 * 176 / 2;
            for (int it = (bx - hG) * 8 + wave; it < I_UPH; it += (G - hG) * 8) transpose_item<true>(p.in[25], 1024, DFF2, WUP, scr, it, lane);
            __syncthreads(); }
        if (bx < hG) for (int vj = bx; vj < 128; vj += hG) {
            const int g = vj >> 2, b = (vj >> 1) & 1, dir = vj & 1, n = lane;
            const f32x2 lam = L16[(g * 2 + dir) * 64 + n];
            float ar = 1.f, ai_ = 0.f;
#pragma unroll 1
            for (int i = 0; i < 66; ++i) { const float nr = ar * lam[0] - ai_ * lam[1], ni = ar * lam[1] + ai_ * lam[0]; ar = nr; ai_ = ni; }
            LAS f32x2* ex = (LAS f32x2*)lds;
            const bf16_t* sbase = SST + (size_t)g * 1280 * 256 + dir * 128 + n;
            const int q0 = wave * 66;
            unsigned sv[66];
#pragma unroll
            for (int j = 0; j < 66; ++j) { const int q = q0 + j; const int row = (q < 16) ? (1024 + b * 16 + (dir ? 15 - q : q)) : (b * 512 + (dir ? 511 - (q - 16) : (q - 16)));
                sv[j] = (unsigned)sbase[(size_t)row * 256] | ((unsigned)sbase[(size_t)row * 256 + 64] << 16); }
            float hr = 0.f, hi_ = 0.f;
#pragma unroll
            for (int j = 0; j < 66; ++j) { const float sr = __uint_as_float(sv[j] << 16), si = __uint_as_float(sv[j] & 0xffff0000u);
                const float nr = hr * lam[0] - hi_ * lam[1] + sr, ni = hr * lam[1] + hi_ * lam[0] + si; hr = nr; hi_ = ni; }
            __syncthreads();
            ex[wave * 64 + n] = (f32x2){hr, hi_};
            __syncthreads();
            hr = 0.f; hi_ = 0.f;
            for (int w2 = 0; w2 < wave; ++w2) { const f32x2 e = ex[w2 * 64 + n]; const float nr = hr * ar - hi_ * ai_ + e[0], ni = hr * ai_ + hi_ * ar + e[1]; hr = nr; hi_ = ni; }
            bf16_t* ubase = US + (size_t)g * 1280 * 512 + 256 + dir * 128 + n;
#pragma unroll
            for (int j = 0; j < 66; ++j) { const int q = q0 + j; const int row = (q < 16) ? (1024 + b * 16 + (dir ? 15 - q : q)) : (b * 512 + (dir ? 511 - (q - 16) : (q - 16)));
                if (q >= 16) { ubase[(size_t)row * 512] = f2bf(hr); ubase[(size_t)row * 512 + 64] = f2bf(hi_); }
                const float sr = __uint_as_float(sv[j] << 16), si = __uint_as_float(sv[j] & 0xffff0000u);
                const float nr = hr * lam[0] - hi_ * lam[1] + sr, ni = hr * lam[1] + hi_ * lam[0] + si; hr = nr; hi_ = ni; }
            __syncthreads();
        }
        for (int vj = bx; vj < 256; vj += G) {
            const int bh = vj >> 5, slice = vj & 31, h = bh & 3, e = slice * 4 + (tid >> 7), col = 2 * (tid & 127), dir = col >> 7;
            const float dec = expf((dir ? ldb[h] : ldf[h]) * 256.0f);
            const bf16_t* kbase = KVT + ((size_t)(bh * 33) * 128 + e) * 256 + col;
            bf16_t* obase = BTU + ((size_t)(bh * 33) * 128 + e) * 512 + 256 + col;
            unsigned kvw[33];
#pragma unroll
            for (int j = 0; j < 33; ++j) kvw[j] = *(const unsigned*)(kbase + (size_t)j * 128 * 256);
            f32x2 R; R[0] = __uint_as_float(kvw[32] << 16); R[1] = __uint_as_float(kvw[32] & 0xffff0000u);
            if (dir == 0) {
#pragma unroll
                for (int cc = 0; cc < 32; ++cc) { *(unsigned*)(obase + (size_t)cc * 128 * 512) = cvt_pk_bf16(R[0], R[1]);
                    R[0] = R[0] * dec + __uint_as_float(kvw[cc] << 16); R[1] = R[1] * dec + __uint_as_float(kvw[cc] & 0xffff0000u); }
            } else {
#pragma unroll
                for (int cc = 31; cc >= 0; --cc) { *(unsigned*)(obase + (size_t)cc * 128 * 512) = cvt_pk_bf16(R[0], R[1]);
                    R[0] = R[0] * dec + __uint_as_float(kvw[cc] << 16); R[1] = R[1] * dec + __uint_as_float(kvw[cc] & 0xffff0000u); }
            }
        }
        { SchedP3 S{G, bx, 0, 256, (const char*)A2U  , (const char*)KB, (const char*)BTU, (const char*)KW, (const char*)US, (const char*)S5E};
          EpiP3 E{EpiS{A2U, ldf, ldb}, EpiKV{KVT}, EpiE{SST}};
          gemm_phase(lds, 512, 256, 256, S, E); }
    }
    GRID_BAR(); }

    for (int rep_ = 0; rep_ < (((REPM >> 5) & 1) ? 2 : 1); ++rep_) { if constexpr ((PM >> 5) & 1) {
        PHASE_IDS
        const int hG = G >> 1;
        { SchedY S{hG, bx < hG ? bx : -1, (const char*)US, (const char*)S5WY}; EpiY E{US, YG, p.in[18]}; gemm_phase(lds, 512, 512, 512, S, E); }
        { SchedO S{G - hG, bx >= hG ? bx - hG : -1, 0, 128, (const char*)A2U, (const char*)BTU}; EpiOLn E{GB, MIX, (LAS f32x2*)(lds + STAGE_BYTES + 64)}; gemm_phase(lds, 512, 512, 512, S, E); }
    }
    GRID_BAR(); }

    for (int rep_ = 0; rep_ < (((REPM >> 6) & 1) ? 2 : 1); ++rep_) { if constexpr ((PM >> 6) & 1) {
        PHASE_IDS
        const int hG = G >> 1;
        { SchedStatic S; S.init(MLAT, 512, 512, 512, YG, WGLU, hG, bx < hG ? bx : (1 << 28)); EpiGlu E{YG, MIX, p.in[20]}; gemm_phase(lds, 512, 512, 512, S, E); }
        { SchedO S{G - hG, bx >= hG ? bx - hG : -1, 128, 256, (const char*)A2U, (const char*)BTU}; EpiOLn E{GB, MIX, (LAS f32x2*)(lds + STAGE_BYTES + 64)}; gemm_phase(lds, 512, 512, 512, S, E); }
        { LAS float* scr = (LAS float*)(lds + wave * 16384); constexpr int I_UP = 16 * 176;
            for (int it = I_UP / 2 + gw; it < I_UP; it += NGW) transpose_item<true>(p.in[25], 1024, DFF2, WUP, scr, it, lane); }
    }
    GRID_BAR(); }

    for (int rep_ = 0; rep_ < (((REPM >> 7) & 1) ? 2 : 1); ++rep_) { if constexpr ((PM >> 7) & 1) {
        PHASE_IDS
        SchedStatic S; S.init(MLAT, 1024, 1024, 1024, MIX, WOUT, G, bx);
        EpiOutNorm E{x, X1B, XN, MOD, p.in[24], RowSq{XCH, CNT}};
        gemm_phase(lds, 1024, 1024, 1024, S, E);
    }
    GRID_BAR(); }

    for (int rep_ = 0; rep_ < (((REPM >> 9) & 1) ? 2 : 1); ++rep_) { if constexpr ((PM >> 9) & 1) {
        PHASE_IDS
        SchedUp S{G, bx, (const char*)XN, (const char*)WUP};
        EpiUpConv E{HAG, p.in[26], p.in[27], (LAS float*)(lds + STAGE_BYTES + 64)};
        gemm_phase(lds, 1024, 1024, 1024, S, E);
        { constexpr int NU = 66 * 22, I_DN = 44 * 32; const int nfull = NU % G;
          LAS float* scr = (LAS float*)(lds + wave * 16384);
          if (nfull > 0) { if (bx >= nfull) for (int it = (bx - nfull) * 8 + wave; it < I_DN; it += (G - nfull) * 8) transpose_item(p.in[28], DFF, 1024, WDOWN, scr, it, lane); }
          else for (int it = gw; it < I_DN; it += NGW) transpose_item(p.in[28], DFF, 1024, WDOWN, scr, it, lane); }
    }
    GRID_BAR(); }

    for (int xs_ = 0; xs_ < NXSYNC; ++xs_) GRID_BAR();
    if constexpr ((PM >> 11) & 1) {
        PHASE_IDS
        SchedStatic S; S.init(MLAT, 1024, DFF, DFF, HAG, WDOWN, G, bx);
        EpiDownNorm E{X1B, p.out, MOD, p.in[29], RowSq{XCH + 65536, CNT + 4096}};
        gemm_phase(lds, DFF, DFF, DFF, S, E);
    }
}

extern "C" void kernel_launch(void* const* d_in, const int* in_sizes, int n_in, void* d_out, int out_size, void* d_ws, size_t ws_size, hipStream_t stream) {
    static int grid = 0;
    if (grid == 0) {
        int dev = 0, cus = 0, per_cu = 0;
        hipGetDevice(&dev);
        hipDeviceGetAttribute(&cus, hipDeviceAttributeMultiprocessorCount, dev);
        hipFuncSetAttribute((const void*)fwd_kernel, hipFuncAttributeMaxDynamicSharedMemorySize, LDS_BYTES);
        hipOccupancyMaxActiveBlocksPerMultiprocessor(&per_cu, (const void*)fwd_kernel, 512, LDS_BYTES);
        if (per_cu < 1) { fprintf(stderr, "kernel_launch: occupancy query says %d blocks per CU\n", per_cu); per_cu = 1; }
        grid = cus;
        (void)hipGetLastError();
    }
    if (hipMemsetAsync((char*)d_ws + WS_BAR, 0, CTL_BYTES, stream) != hipSuccess) { fprintf(stderr, "kernel_launch: memset of the barrier words failed\n"); return; }
    Params p{};
    for (int i = 0; i < 30; ++i) p.in[i] = (const float*)d_in[i];
    p.out = (float*)d_out; p.ws = (unsigned char*)d_ws;
    void* args[] = {&p};
    hipError_t e = hipLaunchCooperativeKernel((const void*)fwd_kernel, dim3(grid), dim3(512), args, LDS_BYTES, stream);
    if (e != hipSuccess) fprintf(stderr, "cooperative launch failed: %s (grid %d)\n", hipGetErrorString(e), grid);
}
```

```cpp
#include <hip/hip_runtime.h>
#include <hip/hip_cooperative_groups.h>
#include <cstdio>
#include <cstdint>
namespace cg = cooperative_groups;

#define LAS __attribute__((address_space(3)))
typedef unsigned short bf16_t;
typedef short bf16x8 __attribute__((ext_vector_type(8)));
typedef float f32x4 __attribute__((ext_vector_type(4)));
typedef float f32x2 __attribute__((ext_vector_type(2)));
typedef unsigned u32x4 __attribute__((ext_vector_type(4)));
typedef unsigned u32x2 __attribute__((ext_vector_type(2)));

constexpr int D = 1024, SEQ = 8192, NB = 2, MLAT = NB * SEQ, CTXL = 256, MCTX = NB * CTXL, MALL = MLAT + MCTX;
constexpr int INC = 2560, DFF = 2816, DFF2 = 5632;
constexpr float EPS = 1e-6f;

constexpr size_t MiB = 1u << 20;
constexpr size_t WS_WIN = 0, WS_S5E = 7 * MiB + MiB / 2, WS_S5WY = 11 * MiB + MiB / 2;
constexpr size_t WS_WUP = 0, WS_WDOWN = 11 * MiB;
constexpr size_t WS_XN = 22 * MiB;
constexpr size_t WS_US = 55 * MiB;
constexpr size_t WS_QB = 95 * MiB, WS_KB = 111 * MiB, WS_GB = 127 * MiB;
constexpr size_t WS_KW = 143 * MiB;
constexpr size_t WS_BTU = 177 * MiB;
constexpr size_t WS_SST = 211 * MiB;
constexpr size_t WS_KVT = 232 * MiB;
constexpr size_t WS_HAG = 55 * MiB;
constexpr size_t WS_BAR = 251 * MiB;
constexpr size_t CTL_BYTES = 65536;
constexpr size_t WS_CNT = WS_BAR + 16384;
constexpr size_t WS_TAB = 251 * MiB + 65536;
constexpr size_t WS_MODP = WS_TAB, WS_MOD = WS_MODP + 8 * 3 * 6144 * 4, WS_ROPE = WS_MOD + 3 * 6144 * 4, WS_L16 = WS_ROPE + 128 * 32 * 8;
constexpr size_t WS_KT = 252 * MiB;
constexpr size_t WS_WOUT = 253 * MiB, WS_WGLU = 255 * MiB;
constexpr size_t WS_XCH = 255 * MiB + MiB / 2;
static_assert(WS_L16 + 32 * 2 * 64 * 8 <= WS_KT, "tables");
static_assert(WS_HAG + (size_t)MLAT * DFF2 * 2 <= 256 * MiB, "ws");

#ifndef REPM
#define REPM 0
#endif
#ifndef NXSYNC
#define NXSYNC 0
#endif
#ifndef SUB
#define SUB 7
#endif
#ifndef PM
#define PM 0xFFFF
#endif

#define XB_TMO      128
#define XB_XCNT(j)  (256  + 64 * (j))
#define XB_XSUB(j)  (1280 + 64 * (j))
#define XB_XGEN(j)  (2304 + 64 * (j))
#define XB_TOP      3328
#define XB_TOPGEN   3392
#define XCD_BAR_WORDS 3456
#define XB_SPIN_CAP (1u << 18)
__device__ __forceinline__ unsigned xb_ld(unsigned* p)              { return __hip_atomic_load(p, __ATOMIC_RELAXED, __HIP_MEMORY_SCOPE_AGENT); }
__device__ __forceinline__ unsigned xb_add(unsigned* p, unsigned v) { return __hip_atomic_fetch_add(p, v, __ATOMIC_RELAXED, __HIP_MEMORY_SCOPE_AGENT); }
__device__ __forceinline__ unsigned xb_xcc_id() { return (unsigned)__builtin_amdgcn_s_getreg((3 << 11) | 20) & 0xFu; }
#define XB_SPIN(cond, bar) do { unsigned _sp = 0; while (cond) { __builtin_amdgcn_s_sleep(1); \
    if ((++_sp & 255u) == 0u) { if (xb_ld(&(bar)[XB_TMO])) break; if (_sp > XB_SPIN_CAP) { atomicAdd(&(bar)[XB_TMO], 1u); break; } } } } while (0)
struct XcdBarrier { unsigned* bar; unsigned x; volatile LAS unsigned* st; };
__device__ __forceinline__ XcdBarrier xcd_barrier_post(unsigned* bar, volatile LAS unsigned* st) {
    XcdBarrier b; b.bar = bar; b.x = xb_xcc_id(); b.st = st;
    if (threadIdx.x == 0) (void)xb_add(&bar[XB_XCNT(b.x)], 1u);
    return b;
}
__device__ __forceinline__ void xcd_barrier_complete(unsigned* bar, unsigned x, unsigned& nloc, unsigned& nx) {
    const unsigned G = gridDim.x * gridDim.y * gridDim.z;
    unsigned sum, cnt, mine, sp = 0u;
    for (;;) {
        sum = 0u; cnt = 0u; mine = 0u;
#pragma unroll
        for (unsigned j = 0; j < 16; ++j) { const unsigned c = xb_ld(&bar[XB_XCNT(j)]); sum += c; cnt += (c > 0u) ? 1u : 0u; mine = (j == x) ? c : mine; }
        if (sum == G) break;
        __builtin_amdgcn_s_sleep(1);
        if ((++sp & 255u) == 0u) { if (xb_ld(&bar[XB_TMO])) break; if (sp > XB_SPIN_CAP) { atomicAdd(&bar[XB_TMO], 1u); break; } }
    }
    nloc = mine > 0u ? mine : 1u; nx = cnt > 0u ? cnt : 1u;
}
__device__ __forceinline__ void xcd_barrier(const XcdBarrier& b) {
    asm volatile("s_waitcnt vmcnt(0)" ::: "memory");
    __syncthreads();
    if (threadIdx.x == 0) {
        unsigned* bar = b.bar;
        __builtin_amdgcn_s_waitcnt(0);
        unsigned nloc = b.st[0], nx = b.st[1];
        if (nloc == 0u) { xcd_barrier_complete(bar, b.x, nloc, nx); b.st[0] = nloc; b.st[1] = nx; }
        const unsigned old = xb_add(&bar[XB_XSUB(b.x)], 1u);
        const unsigned gen = old / nloc;
        if (old + 1u == (gen + 1u) * nloc) {
            __builtin_amdgcn_fence(__ATOMIC_RELEASE, "agent");
            asm volatile("s_waitcnt vmcnt(0)" ::: "memory");
            const unsigned og = xb_add(&bar[XB_TOP], 1u);
            const unsigned tg = og / nx;
            if (og + 1u == (tg + 1u) * nx) xb_add(&bar[XB_TOPGEN], 1u);
            else XB_SPIN(xb_ld(&bar[XB_TOPGEN]) == tg, bar);
            __builtin_amdgcn_fence(__ATOMIC_ACQUIRE, "agent");
            xb_add(&bar[XB_XGEN(b.x)], 1u);
            asm volatile("s_waitcnt vmcnt(0)" ::: "memory");
        } else {
            XB_SPIN(xb_ld(&bar[XB_XGEN(b.x)]) == gen, bar);
            __builtin_amdgcn_fence(__ATOMIC_ACQUIRE, "agent");
            asm volatile("s_waitcnt vmcnt(0)" ::: "memory");
        }
    }
    __syncthreads();
}

struct Params { const float* in[30]; float* out; unsigned char* ws; };

__device__ __forceinline__ unsigned cvt_pk_bf16(float lo, float hi) { unsigned r; asm("v_cvt_pk_bf16_f32 %0, %1, %2" : "=v"(r) : "v"(lo), "v"(hi)); return r; }
__device__ __forceinline__ bf16_t f2bf(float x) { return (bf16_t)(cvt_pk_bf16(x, x) & 0xffffu); }
__device__ __forceinline__ u32x4 pk8(f32x4 lo, f32x4 hi) { u32x4 w; w.x = cvt_pk_bf16(lo[0], lo[1]); w.y = cvt_pk_bf16(lo[2], lo[3]); w.z = cvt_pk_bf16(hi[0], hi[1]); w.w = cvt_pk_bf16(hi[2], hi[3]); return w; }
__device__ __forceinline__ void unpk8(u32x4 w, f32x4& lo, f32x4& hi) {
    lo[0] = __uint_as_float(w.x << 16); lo[1] = __uint_as_float(w.x & 0xffff0000u); lo[2] = __uint_as_float(w.y << 16); lo[3] = __uint_as_float(w.y & 0xffff0000u);
    hi[0] = __uint_as_float(w.z << 16); hi[1] = __uint_as_float(w.z & 0xffff0000u); hi[2] = __uint_as_float(w.w << 16); hi[3] = __uint_as_float(w.w & 0xffff0000u);
}
__device__ __forceinline__ float bf2f(bf16_t h) { return __uint_as_float(((unsigned)h) << 16); }
__device__ __forceinline__ float sigmoidf_(float w) { return __builtin_amdgcn_rcpf(1.0f + __builtin_amdgcn_exp2f(w * -1.4426950408889634f)); }
__device__ __forceinline__ float gelu_tanh(float x) { const float t = x * x, u = fmaf(t, -2.3022081981f * 0.044715f, -2.3022081981f);
    return x * __builtin_amdgcn_rcpf(1.0f + __builtin_amdgcn_exp2f(x * u)); }
__device__ __forceinline__ f32x4 gelu_tanh4(f32x4 x) {
    const f32x4 t = x * x, u = t * (-2.3022081981f * 0.044715f) + (-2.3022081981f), w = x * u;
    f32x4 e; e[0] = __builtin_amdgcn_exp2f(w[0]); e[1] = __builtin_amdgcn_exp2f(w[1]); e[2] = __builtin_amdgcn_exp2f(w[2]); e[3] = __builtin_amdgcn_exp2f(w[3]);
    const f32x4 d = e + 1.0f;
    f32x4 r; r[0] = __builtin_amdgcn_rcpf(d[0]); r[1] = __builtin_amdgcn_rcpf(d[1]); r[2] = __builtin_amdgcn_rcpf(d[2]); r[3] = __builtin_amdgcn_rcpf(d[3]);
    return x * r;
}
__device__ __forceinline__ float silu_(float x) { return x * sigmoidf_(x); }
__device__ __forceinline__ float wave_sum(float v) {
#pragma unroll
    for (int o = 1; o < 64; o <<= 1) v += __shfl_xor(v, o);
    return v;
}
__device__ __forceinline__ void sincos_red(float th, float& s, float& c) {
    const float k = rintf(th * 0.15915494309189535f);
    float r = fmaf(-k, 6.28125f, th);
    r = fmaf(-k, 1.9353071795864769e-3f, r);
    sincosf(r, &s, &c);
}

constexpr int BM = 256, BK = 64, HALF = 128, HTB = HALF * BK * 2, STAGE_BYTES = 8 * HTB, NXCD = 8, WGM = 8;
__device__ __forceinline__ int lds_byte(int r, int c) { const int st = (r >> 4) * 2 + (c >> 5), rr = r & 15, cc = c & 31, ob = rr * 64 + cc * 2; return st * 1024 + (ob ^ (((ob >> 9) & 1) << 5)); }
__device__ __forceinline__ void stage_rc(int b, int& R, int& C) { const int st = b / 1024, sb = b % 1024, swz = sb ^ (((sb >> 9) & 1) << 5); R = (st >> 1) * 16 + swz / 64; C = (st & 1) * 32 + (swz % 64) / 2; }
__device__ __forceinline__ int perm32(int rho) { const int n = rho >> 4, i = rho & 15; return 8 * (i >> 2) + 4 * n + (i & 3); }

struct Unit { int pm, pn; const char* a; const char* b; int nt, ty; };

template <class Epi, class Sched>
__device__ __forceinline__ void gemm_phase(LAS unsigned char* lds, const int lda, const int ldb, const int K, const Sched& S, const Epi& E) {
    int tid_ = threadIdx.x; asm volatile("" : "+v"(tid_));
    const int tid = tid_, wid = __builtin_amdgcn_readfirstlane(tid >> 6), lane = tid & 63, wr = wid >> 2, wc = wid & 3, fr = lane & 15, fq = lane >> 4;
    const int nt_call = K / BK;
    unsigned voffA[2], voffB[2];
#pragma unroll
    for (int i = 0; i < 2; ++i) { int R, C; stage_rc(tid * 16 + i * 8192, R, C); const int Rb = (R & ~31) + perm32(R & 31);
        voffA[i] = (unsigned)(R * lda + C) * 2u; voffB[i] = (unsigned)(Rb * ldb + C) * 2u; }
    const size_t kstep = (size_t)(BK * 2);
    const size_t hstepA = (size_t)HALF * lda * 2, hstepB = (size_t)HALF * ldb * 2;
    const unsigned ldsw = (unsigned)wid * 1024u;
    const int aoff = lds_byte(wr * 64 + fr, fq * 8), boff = lds_byte(wc * 32 + fr, fq * 8);
#define PG8_SA(b, h) (((b) * 2 + (h)) * HTB)
#define PG8_SB(b, h) ((4 + (b) * 2 + (h)) * HTB)
#define PG8_STAGE(bufoff, gbase, voff) do { _Pragma("unroll") for (int _i = 0; _i < 2; ++_i) \
        __builtin_amdgcn_global_load_lds((const unsigned*)((const char*)(gbase) + (voff)[_i]), (LAS unsigned*)(lds + (bufoff) + ldsw + _i * 8192), 16, 0, 0); } while (0)
#define PG8_LDA(dst, b, h) do { _Pragma("unroll") for (int m = 0; m < 4; ++m) _Pragma("unroll") for (int k = 0; k < 2; ++k) dst[m][k] = *(const LAS bf16x8*)(lds + PG8_SA(b, h) + aoff + m * 2048 + k * 1024); } while (0)
#define PG8_LDB(dst, b, h) do { _Pragma("unroll") for (int n = 0; n < 2; ++n) _Pragma("unroll") for (int k = 0; k < 2; ++k) dst[n][k] = *(const LAS bf16x8*)(lds + PG8_SB(b, h) + boff + n * 2048 + k * 1024); } while (0)
#define PG8_MMA(ai, bj, At, Bt) do { __builtin_amdgcn_s_setprio(1); _Pragma("unroll") for (int m = 0; m < 4; ++m) _Pragma("unroll") for (int n = 0; n < 2; ++n) _Pragma("unroll") for (int k = 0; k < 2; ++k) \
        acc[ai][bj][m][n] = __builtin_amdgcn_mfma_f32_16x16x32_bf16(Bt[n][k], At[m][k], acc[ai][bj][m][n], 0, 0, 0); __builtin_amdgcn_s_setprio(0); } while (0)
#define PG8_WAIT_V(n) asm volatile("s_waitcnt vmcnt(" #n ")" ::: "memory")
#define PG8_WAIT_L(n) asm volatile("s_waitcnt lgkmcnt(" #n ")" ::: "memory")
#define PG8_BAR __builtin_amdgcn_s_barrier()
#define PG8_SCHED __builtin_amdgcn_sched_barrier(0)
    Unit cur, nxt; int ui = 0;
    cur.nt = 0; cur.ty = 0; nxt.nt = 0; nxt.ty = 0;
    if (!S.next(0, cur)) return;
    f32x4 acc[2][2][4][2];
#pragma unroll
    for (int a = 0; a < 2; ++a)
#pragma unroll
        for (int b = 0; b < 2; ++b)
#pragma unroll
            for (int m = 0; m < 4; ++m)
#pragma unroll
                for (int n = 0; n < 2; ++n) acc[a][b][m][n] = (f32x4){0.f, 0.f, 0.f, 0.f};
    bf16x8 At[4][2], B0[2][2], B1[2][2];
    const char* cA = cur.a; const char* cB = cur.b;
    PG8_STAGE(PG8_SB(0, 0), cB, voffB); PG8_STAGE(PG8_SB(0, 1), cB + hstepB, voffB); PG8_STAGE(PG8_SA(0, 0), cA, voffA); PG8_STAGE(PG8_SA(0, 1), cA + hstepA, voffA);
    if (wr == 1) PG8_BAR;
    PG8_WAIT_V(2); PG8_BAR;
    PG8_STAGE(PG8_SB(1, 0), cB + kstep, voffB); PG8_STAGE(PG8_SA(1, 0), cA + kstep, voffA); PG8_STAGE(PG8_SB(1, 1), cB + hstepB + kstep, voffB);
    PG8_WAIT_V(6); PG8_BAR;
    for (;;) {
        nxt.nt = 0; nxt.ty = 0;
        const bool has_next = S.next(ui + 1, nxt);
        const int nt = cur.nt ? cur.nt : nt_call;
        const char* nA = has_next ? nxt.a : cA; const char* nB = has_next ? nxt.b : cB;
        for (int t = 0; t < nt; t += 2) {
            const bool last = (t == nt - 2);
            const char* a1 = cA + (size_t)(t + 1) * kstep;
            const char* a2 = last ? nA : cA + (size_t)(t + 2) * kstep; const char* b2 = last ? nB : cB + (size_t)(t + 2) * kstep;
            const char* a3 = a2 + kstep; const char* b3 = b2 + kstep;
            PG8_LDB(B0, 0, 0); PG8_LDB(B1, 0, 1); PG8_SCHED; PG8_LDA(At, 0, 0); PG8_STAGE(PG8_SA(1, 1), a1 + hstepA, voffA);
            PG8_WAIT_V(8); PG8_WAIT_L(0); PG8_BAR; PG8_MMA(0, 0, At, B0); PG8_MMA(0, 1, At, B1); PG8_BAR; PG8_SCHED;
            PG8_LDA(At, 0, 1); PG8_STAGE(PG8_SB(0, 0), b2, voffB); PG8_STAGE(PG8_SB(0, 1), b2 + hstepB, voffB); PG8_STAGE(PG8_SA(0, 0), a2, voffA);
            PG8_WAIT_V(8); PG8_WAIT_L(0); PG8_BAR; PG8_MMA(1, 0, At, B0); PG8_MMA(1, 1, At, B1); PG8_BAR; PG8_SCHED;
            PG8_LDB(B0, 1, 0); PG8_LDB(B1, 1, 1); PG8_SCHED; PG8_LDA(At, 1, 0); PG8_STAGE(PG8_SA(0, 1), a2 + hstepA, voffA);
            PG8_WAIT_V(8); PG8_WAIT_L(0); PG8_BAR; PG8_MMA(0, 0, At, B0); PG8_MMA(0, 1, At, B1); PG8_BAR; PG8_SCHED;
            PG8_LDA(At, 1, 1); PG8_STAGE(PG8_SB(1, 0), b3, voffB); PG8_STAGE(PG8_SB(1, 1), b3 + hstepB, voffB); PG8_STAGE(PG8_SA(1, 0), a3, voffA);
            PG8_WAIT_V(8); PG8_WAIT_L(0); PG8_BAR; PG8_MMA(1, 0, At, B0); PG8_MMA(1, 1, At, B1); PG8_BAR; PG8_SCHED;
        }
        if (wr == 0) PG8_BAR;
        if constexpr (!Epi::AFTER_DRAIN) { int fr_ = fr, fq_ = fq, wr_ = wr, wc_ = wc; asm volatile("" : "+v"(fr_), "+v"(fq_), "+s"(wr_), "+s"(wc_));
          E(acc, cur, wr_, wc_, fr_, fq_); }
        if (!has_next) break;
#pragma unroll
        for (int a = 0; a < 2; ++a)
#pragma unroll
            for (int b = 0; b < 2; ++b)
#pragma unroll
                for (int m = 0; m < 4; ++m)
#pragma unroll
                    for (int n = 0; n < 2; ++n) acc[a][b][m][n] = (f32x4){0.f, 0.f, 0.f, 0.f};
        cur = nxt; cA = nA; cB = nB; ++ui;
        if (wr == 1) PG8_BAR;
    }
    PG8_WAIT_V(0);
    PG8_BAR;
    if constexpr (Epi::AFTER_DRAIN) {
        int fr_ = fr, fq_ = fq, wr_ = wr, wc_ = wc, ln_ = lane; asm volatile("" : "+v"(fr_), "+v"(fq_), "+s"(wr_), "+s"(wc_), "+v"(ln_));
        E.fused(acc, cur, wr_, wc_, fr_, fq_, lds, wid, ln_); }
#undef PG8_SA
#undef PG8_SB
#undef PG8_STAGE
#undef PG8_LDA
#undef PG8_LDB
#undef PG8_MMA
#undef PG8_WAIT_V
#undef PG8_WAIT_L
#undef PG8_BAR
#undef PG8_SCHED
}

#define EPI_LOOP_BEGIN \
    _Pragma("unroll") for (int ai = 0; ai < 2; ++ai) _Pragma("unroll") for (int m = 0; m < 4; ++m) { const int rl = ai * 128 + wr * 64 + m * 16 + fr; \
    _Pragma("unroll") for (int bj = 0; bj < 2; ++bj) { const int cl = bj * 128 + wc * 32 + 8 * fq; f32x4 lo = acc[ai][bj][m][0], hi = acc[ai][bj][m][1];
#define EPI_LOOP_END } }

struct SchedStatic {
    int nM, nN, nwg, G, c; const char* A; const char* B; size_t ta, tb;
    __device__ __forceinline__ void init(int M, int N, int lda, int ldb, const void* A_, const void* B_, int G_, int c_) { nM = M / BM; nN = N / BM; nwg = nM * nN; G = G_; c = c_; A = (const char*)A_; B = (const char*)B_; ta = (size_t)BM * lda * 2; tb = (size_t)BM * ldb * 2; }
    __device__ __forceinline__ bool next(int i, Unit& u) const {
        const long L = (long)i * G + c; if (L >= nwg) return false;
        int wgid = (int)L; { const int q = nwg / NXCD, r = nwg % NXCD, xcd = wgid % NXCD, off = wgid / NXCD; wgid = (xcd < r ? xcd * (q + 1) : r * (q + 1) + (xcd - r) * q) + off; }
        const int nig = WGM * nN, gid = wgid / nig, fm = gid * WGM, gsz = (nM - fm) < WGM ? (nM - fm) : WGM;
        u.pm = fm + ((wgid % nig) % gsz); u.pn = (wgid % nig) / gsz; u.a = A + (size_t)u.pm * ta; u.b = B + (size_t)u.pn * tb; return true;
    }
};
struct SchedIn {
    int nM, nN, nwg, G, c, o1, o2; const char* A; const char* B;
    int t0, t1, tb;
    __device__ __forceinline__ bool next(int i, Unit& u) const {
        if (c < 0) return false;
        const long L = (long)i * G + c;
        if (L >= nwg) { const int t = t0 + (int)(L - nwg); if (t >= t1) return false;
            u.pm = t & 63; u.pn = tb + (t >> 6); u.a = A + (size_t)u.pm * (256 * 1024 * 2); u.b = B + (size_t)u.pn * (256 * 1024 * 2); return true; }
        int wgid = (int)L; { const int q = nwg / NXCD, r = nwg % NXCD, xcd = wgid % NXCD, off = wgid / NXCD; wgid = (xcd < r ? xcd * (q + 1) : r * (q + 1) + (xcd - r) * q) + off; }
        const int nig = WGM * nN, gid = wgid / nig, fm = gid * WGM, gsz = (nM - fm) < WGM ? (nM - fm) : WGM;
        u.pm = fm + ((wgid % nig) % gsz); const int j = (wgid % nig) / gsz; u.pn = (nN == 6) ? (j < 4 ? j + 4 : j - 4) : j + (j < 2 ? o1 : o2);
        u.a = A + (size_t)u.pm * (256 * 1024 * 2); u.b = B + (size_t)u.pn * (256 * 1024 * 2); return true;
    }
};
struct SchedP3 {
    int G, c, base, lim; const char* QB; const char* KB; const char* BTU; const char* KW; const char* US; const char* S5E;
    __device__ __forceinline__ bool next(int i, Unit& u) const {
        if (c < 0) return false;
        int L = base + i * G + c; if (L >= lim) return false;
        if (L < 256) { const int bh = L >> 5, cc = L & 31, b = bh >> 2, h = bh & 3;
            u.pm = L; u.pn = h; u.nt = 2; u.ty = 0;
            u.a = QB + ((size_t)L * 256 * 512 + 256) * 2; u.b = KB + (((size_t)((b * 2 + (h >> 1)) * SEQ + cc * 256)) * 256 + (h & 1) * 128) * 2; return true; }
        L -= 256;
        if (L < 264) { u.pm = L; u.pn = 0; u.nt = 4; u.ty = 1; u.a = BTU + (size_t)L * 131072; u.b = KW + (size_t)L * 131072; return true; }
        L -= 264;
        if (L < 160) { const int g = L / 5, pml = L % 5; u.pm = pml; u.pn = g; u.nt = 4; u.ty = 2;
            u.a = US + ((size_t)(g * 1280 + pml * 256) * 512) * 2; u.b = S5E + (size_t)g * 256 * 256 * 2; return true; }
        return false;
    }
};
struct SchedO {
    int G, c, base, lim; const char* A2U; const char* BTU;
    __device__ __forceinline__ bool next(int i, Unit& u) const {
        if (c < 0) return false;
        const int L = base + i * G + c; if (L >= lim) return false;
        const int bh = L >> 5, cc = L & 31; u.pm = L; u.pn = bh & 3; u.a = A2U + (size_t)L * 262144; u.b = BTU + (size_t)(bh * 33 + cc) * 131072; return true; }
};
struct SchedY {
    int G, c; const char* US; const char* WY;
    __device__ __forceinline__ bool next(int i, Unit& u) const {
        if (c < 0) return false;
        const int L = i * G + c; if (L >= 128) return false;
        const int g = L >> 2, pml = L & 3; u.pm = pml; u.pn = g; u.a = US + ((size_t)(g * 1280 + pml * 256) * 512) * 2; u.b = WY + (size_t)g * 256 * 512 * 2; return true; }
};

__device__ __forceinline__ void rope8(f32x4& lo, f32x4& hi, const f32x2* rope, int t, int d) {
    const int j0 = d >> 1, pos = (j0 < 32) ? (t >> 6) : (t & 63);
    const f32x4* cs = (const f32x4*)(rope + pos * 32 + (j0 & 31));
    const f32x4 c01 = cs[0], c23 = cs[1];
    float a, b;
    a = lo[0]; b = lo[1]; lo[0] = a * c01[0] - b * c01[1]; lo[1] = a * c01[1] + b * c01[0];
    a = lo[2]; b = lo[3]; lo[2] = a * c01[2] - b * c01[3]; lo[3] = a * c01[3] + b * c01[2];
    a = hi[0]; b = hi[1]; hi[0] = a * c23[0] - b * c23[1]; hi[1] = a * c23[1] + b * c23[0];
    a = hi[2]; b = hi[3]; hi[2] = a * c23[2] - b * c23[3]; hi[3] = a * c23[3] + b * c23[2];
}


__device__ __forceinline__ unsigned dpp_swap1(unsigned v) { return (unsigned)__builtin_amdgcn_update_dpp(0, (int)v, 0xB1, 0xf, 0xf, false); }
__device__ __forceinline__ void pair_pack(f32x4 lo, f32x4 hi, bool odd, unsigned (&o)[4]) {
    const unsigned p01 = cvt_pk_bf16(lo[0], lo[1]), p23 = cvt_pk_bf16(lo[2], lo[3]), p45 = cvt_pk_bf16(hi[0], hi[1]), p67 = cvt_pk_bf16(hi[2], hi[3]);
    const unsigned r0 = dpp_swap1(odd ? p01 : p45), r1 = dpp_swap1(odd ? p23 : p67);
    const unsigned kA = odd ? p45 : p01, kB = odd ? p67 : p23;
    const unsigned eA = odd ? r0 : kA, oA = odd ? kA : r0, eB = odd ? r1 : kB, oB = odd ? kB : r1;
    o[0] = (eA & 0xffffu) | (oA << 16); o[1] = (eA >> 16) | (oA & 0xffff0000u); o[2] = (eB & 0xffffu) | (oB << 16); o[3] = (eB >> 16) | (oB & 0xffff0000u);
}
struct EpiIn {
    static constexpr bool AFTER_DRAIN = false;
    bf16_t *US, *QB, *KB, *GB, *KW, *BTU, *A2U; const f32x2* rope; const float* ldf; const float* ldb;
    __device__ __forceinline__ void operator()(const f32x4 (&acc)[2][2][4][2], const Unit& u, int wr, int wc, int fr, int fq) const {
        const int region = u.pn >> 1; const bool isctx = u.pm >= 64;
        if (isctx && (region == 1 || region == 4)) return;
        const int cb = (u.pn & 1) * 256;
        if (region == 0) {
            EPI_LOOP_BEGIN
                const int r = u.pm * 256 + rl; int b, t;
                if (!isctx) { b = r >> 13; t = r & 8191; } else { const int rc = r - MLAT; b = rc >> 8; t = rc & 255; }
                const int c = cb + cl, g = c >> 4, p0 = c & 15;
                const int crow = isctx ? (1024 + b * 16 + (t >> 4)) : (b * 512 + (t >> 4));
                *(u32x4*)(US + ((size_t)(g * 1280 + crow) * 512 + (t & 15) * 16 + p0)) = pk8(lo, hi);
            EPI_LOOP_END
        } else if (region == 1) {
            EPI_LOOP_BEGIN
                const int r = u.pm * 256 + rl, b = r >> 13, t = r & 8191;
                const int c = cb + cl, h = c >> 7, d = c & 127;
                rope8(lo, hi, rope, t, d);
                const int u2 = (b * 4 + h) * 32 + (t >> 8), cc = t & 255;
                const float wf = __expf(ldf[h] * (float)(cc + 1)), wb = __expf(ldb[h] * (float)(256 - cc));
                bf16_t* dst = A2U + ((size_t)u2 * 256 + cc) * 512 + 256 + d;
                *(u32x4*)dst = pk8(lo * wf, hi * wf);
                *(u32x4*)(dst + 128) = pk8(lo * wb, hi * wb);
            EPI_LOOP_END
        } else if (region == 2) {
            EPI_LOOP_BEGIN
                const int r = u.pm * 256 + rl; int b, t;
                if (!isctx) { b = r >> 13; t = r & 8191; } else { const int rc = r - MLAT; b = rc >> 8; t = rc & 255; }
                const int c = cb + cl, h = c >> 7, d = c & 127;
                lo = lo * 0.08838834764831845f; hi = hi * 0.08838834764831845f;
                int ku, mm;
                if (!isctx) { rope8(lo, hi, rope, t, d); *(u32x4*)(KB + ((size_t)((b * 2 + (h >> 1)) * SEQ + t)) * 256 + (h & 1) * 128 + d) = pk8(lo, hi); ku = (b * 4 + h) * 33 + (t >> 8); mm = t & 255; }
                else { ku = (b * 4 + h) * 33 + 32; mm = t; }
                const float wf = __expf(ldf[h] * (float)(255 - mm)), wb = __expf(ldb[h] * (float)mm);
                const bool odd = fr & 1; unsigned pf[4], pb[4];
                pair_pack(lo * wf, hi * wf, odd, pf); pair_pack(lo * wb, hi * wb, odd, pb);
                bf16_t* dst = KW + ((size_t)ku * 256 + d + (odd ? 4 : 0)) * 256 + (mm & ~1);
#pragma unroll
                for (int i = 0; i < 4; ++i) { *(unsigned*)(dst + i * 256) = pf[i]; *(unsigned*)(dst + (128 + i) * 256) = pb[i]; }
            EPI_LOOP_END
        } else if (region == 3) {
            EPI_LOOP_BEGIN
                const int r = u.pm * 256 + rl; int b, t;
                if (!isctx) { b = r >> 13; t = r & 8191; } else { const int rc = r - MLAT; b = rc >> 8; t = rc & 255; }
                const int c = cb + cl, h = c >> 7, e = c & 127;
                const int ku = isctx ? ((b * 4 + h) * 33 + 32) : ((b * 4 + h) * 33 + (t >> 8)); const int mm = isctx ? t : (t & 255);
                const bool odd = fr & 1; unsigned pv[4]; pair_pack(lo, hi, odd, pv);
                bf16_t* dst = BTU + ((size_t)ku * 128 + e + (odd ? 4 : 0)) * 512 + (mm & ~1);
#pragma unroll
                for (int i = 0; i < 4; ++i) *(unsigned*)(dst + i * 512) = pv[i];
            EPI_LOOP_END
        } else {
            EPI_LOOP_BEGIN
                *(u32x4*)(GB + (size_t)(u.pm * 256 + rl) * 512 + cb + cl) = pk8(lo, hi);
            EPI_LOOP_END
        }
    }
};
struct EpiS {
    static constexpr bool AFTER_DRAIN = false;
    bf16_t* A2U; const float* ldf; const float* ldb;
    __device__ __forceinline__ void operator()(const f32x4 (&acc)[2][2][4][2], const Unit& u, int wr, int wc, int fr, int fq) const {
        const float lf = ldf[u.pn], nlb = -ldb[u.pn];
        EPI_LOOP_BEGIN
            const float dd = (float)(rl - cl), rt = -lf * (float)(rl + 1);
#pragma unroll
            for (int i = 0; i < 4; ++i) {
                const float d0 = dd - (float)i, d1 = dd - (float)(4 + i);
                lo[i] *= __expf(fminf(lf * d0, nlb * d0) + rt);
                hi[i] *= __expf(fminf(lf * d1, nlb * d1) + rt);
            }
            *(u32x4*)(A2U + ((size_t)u.pm * 256 + rl) * 512 + cl) = pk8(lo, hi);
        EPI_LOOP_END
    }
};
struct EpiKV {
    static constexpr bool AFTER_DRAIN = false;
    bf16_t* KVT;
    __device__ __forceinline__ void operator()(const f32x4 (&acc)[2][2][4][2], const Unit& u, int wr, int wc, int fr, int fq) const {
        EPI_LOOP_BEGIN
            if (ai == 0) *(u32x4*)(KVT + ((size_t)u.pm * 128 + rl) * 256 + cl) = pk8(lo, hi);
        EPI_LOOP_END
    }
};
struct EpiE {
    static constexpr bool AFTER_DRAIN = false;
    bf16_t* SST;
    __device__ __forceinline__ void operator()(const f32x4 (&acc)[2][2][4][2], const Unit& u, int wr, int wc, int fr, int fq) const {
        EPI_LOOP_BEGIN
            if (u.pm * 256 + rl < 1056) *(u32x4*)(SST + ((size_t)(u.pn * 1280 + u.pm * 256 + rl)) * 256 + cl) = pk8(lo, hi);
        EPI_LOOP_END
    }
};
struct EpiOLn {
    static constexpr bool AFTER_DRAIN = false;
    const bf16_t* GB; bf16_t* MIX; LAS f32x2* T;
    __device__ __forceinline__ void operator()(const f32x4 (&acc)[2][2][4][2], const Unit& u, int wr, int wc, int fr, int fq) const {
        const int bh = u.pm >> 5, cc = u.pm & 31, b = bh >> 2, h = bh & 3, cx = wc * 32 + 8 * fq;
#pragma unroll
        for (int ai = 0; ai < 2; ++ai)
#pragma unroll
            for (int m = 0; m < 4; ++m) { const f32x4 lo = acc[ai][0][m][0], hi = acc[ai][0][m][1];
                float sm = (lo[0] + lo[1]) + (lo[2] + lo[3]) + (hi[0] + hi[1]) + (hi[2] + hi[3]);
                float sq = (lo[0] * lo[0] + lo[1] * lo[1]) + (lo[2] * lo[2] + lo[3] * lo[3]) + (hi[0] * hi[0] + hi[1] * hi[1]) + (hi[2] * hi[2] + hi[3] * hi[3]);
                sm += __shfl_xor(sm, 16); sm += __shfl_xor(sm, 32); sq += __shfl_xor(sq, 16); sq += __shfl_xor(sq, 32);
                if (fq == 0) T[(ai * 128 + wr * 64 + m * 16 + fr) * 4 + wc] = (f32x2){sm, sq}; }
        asm volatile("s_waitcnt lgkmcnt(0)" ::: "memory"); __builtin_amdgcn_s_barrier(); asm volatile("" ::: "memory");
#pragma unroll
        for (int ai = 0; ai < 2; ++ai)
#pragma unroll
            for (int m = 0; m < 4; ++m) { const int rl = ai * 128 + wr * 64 + m * 16 + fr;
                const f32x4 t01 = *(const LAS f32x4*)(T + rl * 4), t23 = *(const LAS f32x4*)(T + rl * 4 + 2);
                const float S1 = (t01[0] + t01[2]) + (t23[0] + t23[2]), S2 = (t01[1] + t01[3]) + (t23[1] + t23[3]);
                const float mu = S1 * (1.0f / 128.0f), var = fmaxf(S2 * (1.0f / 128.0f) - mu * mu, 0.0f), rs = __builtin_amdgcn_rsqf(var + EPS);
                const size_t row = (size_t)(b * SEQ + cc * 256 + rl);
                f32x4 g0, g1; unpk8(*(const u32x4*)(GB + row * 512 + h * 128 + cx), g0, g1);
                f32x4 y0 = (acc[ai][0][m][0] - mu) * rs, y1 = (acc[ai][0][m][1] - mu) * rs;
#pragma unroll
                for (int i = 0; i < 4; ++i) { y0[i] *= silu_(g0[i]); y1[i] *= silu_(g1[i]); }
                *(u32x4*)(MIX + row * 1024 + 512 + h * 128 + cx) = pk8(y0, y1);
                __builtin_amdgcn_sched_barrier(0); }
    }
};
struct EpiY {
    static constexpr bool AFTER_DRAIN = false;
    const bf16_t* US; bf16_t* YG; const float* s5d;
    __device__ __forceinline__ void operator()(const f32x4 (&acc)[2][2][4][2], const Unit& u, int wr, int wc, int fr, int fq) const {
        const int g = u.pn;
        EPI_LOOP_BEGIN
            const int cr = u.pm * 256 + rl, b = cr >> 9, cc = cr & 511, t = cl >> 4, p0 = cl & 15;
            const u32x4 uw = *(const u32x4*)(US + ((size_t)(g * 1280 + cr) * 512 + cl));
            f32x4 ul, uh; unpk8(uw, ul, uh);
            const f32x4 d0 = *(const f32x4*)(s5d + g * 16 + p0), d1 = *(const f32x4*)(s5d + g * 16 + p0 + 4);
            lo = lo + d0 * ul; hi = hi + d1 * uh;
#pragma unroll
            for (int i = 0; i < 1; ++i) { lo = gelu_tanh4(lo); hi = gelu_tanh4(hi); }
            *(u32x4*)(YG + ((size_t)(b * SEQ + cc * 16 + t)) * 512 + g * 16 + p0) = pk8(lo, hi);
        EPI_LOOP_END
    }
};
struct EpiP3 { static constexpr bool AFTER_DRAIN = false; EpiS s; EpiKV kv; EpiE e;
    __device__ __forceinline__ void operator()(const f32x4 (&acc)[2][2][4][2], const Unit& u, int wr, int wc, int fr, int fq) const { if (u.ty == 0) s(acc, u, wr, wc, fr, fq); else if (u.ty == 1) kv(acc, u, wr, wc, fr, fq); else e(acc, u, wr, wc, fr, fq); } };
struct EpiGlu {
    static constexpr bool AFTER_DRAIN = false;
    const bf16_t* YG; bf16_t* MIX; const float* bglu;
    __device__ __forceinline__ void operator()(const f32x4 (&acc)[2][2][4][2], const Unit& u, int wr, int wc, int fr, int fq) const {
        EPI_LOOP_BEGIN
            const int r = u.pm * 256 + rl, c = u.pn * 256 + cl;
            const u32x4 yw = *(const u32x4*)(YG + (size_t)r * 512 + c); f32x4 yl, yh; unpk8(yw, yl, yh);
            const f32x4 b0 = *(const f32x4*)(bglu + c), b1 = *(const f32x4*)(bglu + c + 4);
            lo = lo + b0; hi = hi + b1;
#pragma unroll
            for (int i = 0; i < 4; ++i) { lo[i] = yl[i] * sigmoidf_(lo[i]); hi[i] = yh[i] * sigmoidf_(hi[i]); }
            *(u32x4*)(MIX + (size_t)r * 1024 + c) = pk8(lo, hi);
        EPI_LOOP_END
    }
};
struct EpiRes {
    static constexpr bool AFTER_DRAIN = false;
    const float* base; float* out; const float* gate;
    __device__ __forceinline__ void operator()(const f32x4 (&acc)[2][2][4][2], const Unit& u, int wr, int wc, int fr, int fq) const {
        EPI_LOOP_BEGIN
            const int r = u.pm * 256 + rl, c = u.pn * 256 + cl, b = r >> 13;
            const float* gp = gate + b * 6144 + c; const f32x4 g0 = *(const f32x4*)gp, g1 = *(const f32x4*)(gp + 4);
            const float* bp = base + (size_t)r * 1024 + c; const f32x4 x0 = *(const f32x4*)bp, x1 = *(const f32x4*)(bp + 4);
            float* op = out + (size_t)r * 1024 + c; *(f32x4*)op = x0 + g0 * lo; *(f32x4*)(op + 4) = x1 + g1 * hi;
        EPI_LOOP_END
    }
};
struct EpiUp {
    static constexpr bool AFTER_DRAIN = false;
    bf16_t* H;
    __device__ __forceinline__ void operator()(const f32x4 (&acc)[2][2][4][2], const Unit& u, int wr, int wc, int fr, int fq) const {
        EPI_LOOP_BEGIN
            *(u32x4*)(H + (size_t)(u.pm * 256 + rl) * DFF2 + u.pn * 256 + cl) = pk8(lo, hi);
        EPI_LOOP_END
    }
};


struct SchedUp {
    int G, c; const char* A; const char* B;
    __device__ __forceinline__ bool next(int i, Unit& u) const {
        constexpr int nM = 66, nN = 22, nwg = nM * nN;
        const int L = i * G + c; if (L >= nwg) return false;
        int wgid = L; { const int q = nwg / NXCD, r = nwg % NXCD, xcd = wgid % NXCD, off = wgid / NXCD; wgid = (xcd < r ? xcd * (q + 1) : r * (q + 1) + (xcd - r) * q) + off; }
        const int nig = WGM * nN, gid = wgid / nig, fm = gid * WGM, gsz = (nM - fm) < WGM ? (nM - fm) : WGM;
        u.pm = fm + ((wgid % nig) % gsz); u.pn = (wgid % nig) / gsz;
        const int b = u.pm / 33, j = u.pm - b * 33; int st = 254 * j - 1; st = st < 0 ? 0 : (st > 7936 ? 7936 : st);
        u.a = A + ((size_t)(b * SEQ + st)) * 1024 * 2; u.b = B + (size_t)u.pn * 256 * 1024 * 2; return true;
    }
};
__device__ __forceinline__ float dpp_ror1(float v) { return __int_as_float(__builtin_amdgcn_update_dpp(0, __float_as_int(v), 0x121, 0xf, 0xf, false)); }
__device__ __forceinline__ float dpp_ror15(float v) { return __int_as_float(__builtin_amdgcn_update_dpp(0, __float_as_int(v), 0x12F, 0xf, 0xf, false)); }
__device__ __forceinline__ f32x4 ror1_4(f32x4 v) { f32x4 r; r[0] = dpp_ror1(v[0]); r[1] = dpp_ror1(v[1]); r[2] = dpp_ror1(v[2]); r[3] = dpp_ror1(v[3]); return r; }
__device__ __forceinline__ f32x4 rol1_4(f32x4 v) { f32x4 r; r[0] = dpp_ror15(v[0]); r[1] = dpp_ror15(v[1]); r[2] = dpp_ror15(v[2]); r[3] = dpp_ror15(v[3]); return r; }
struct EpiUpConv {
    static constexpr bool AFTER_DRAIN = false;
    bf16_t* HH; const float* cw; const float* cbias; LAS float* X;
    __device__ __forceinline__ void operator()(const f32x4 (&acc)[2][2][4][2], const Unit& u, int wr, int wc, int fr, int fq) const {
        const int b = u.pm / 33, j = u.pm - b * 33; int st = 254 * j - 1; st = st < 0 ? 0 : (st > 7936 ? 7936 : st);
        const int cx = wc * 32 + 8 * fq, F = u.pn * 128 + cx;
        const f32x4 w0l = *(const f32x4*)(cw + F), w0h = *(const f32x4*)(cw + F + 4), w1l = *(const f32x4*)(cw + DFF + F), w1h = *(const f32x4*)(cw + DFF + F + 4),
                    w2l = *(const f32x4*)(cw + 2 * DFF + F), w2h = *(const f32x4*)(cw + 2 * DFF + F + 4), bl = *(const f32x4*)(cbias + F), bh = *(const f32x4*)(cbias + F + 4);
#pragma unroll
        for (int ai = 0; ai < 2; ++ai) { const int blk = ai * 2 + wr;
            if (fr == 0) { LAS float* d = X + (blk * 2 + 0) * 128 + cx; *(LAS f32x4*)d = acc[ai][1][0][0]; *(LAS f32x4*)(d + 4) = acc[ai][1][0][1]; }
            if (fr == 15) { LAS float* d = X + (blk * 2 + 1) * 128 + cx; *(LAS f32x4*)d = acc[ai][1][3][0]; *(LAS f32x4*)(d + 4) = acc[ai][1][3][1]; } }
        asm volatile("s_waitcnt lgkmcnt(0)" ::: "memory"); __builtin_amdgcn_s_barrier(); asm volatile("" ::: "memory");
        const f32x4 z4 = (f32x4){0.f, 0.f, 0.f, 0.f};
#pragma unroll
        for (int ai = 0; ai < 2; ++ai) { const int blk = ai * 2 + wr;
            f32x4 xpl = z4, xph = z4, xnl = z4, xnh = z4;
            if (blk > 0) { const LAS float* q = X + ((blk - 1) * 2 + 1) * 128 + cx; xpl = *(const LAS f32x4*)q; xph = *(const LAS f32x4*)(q + 4); }
            if (blk < 3) { const LAS float* q = X + ((blk + 1) * 2 + 0) * 128 + cx; xnl = *(const LAS f32x4*)q; xnh = *(const LAS f32x4*)(q + 4); }
            f32x4 rpl = xpl, rph = xph;
            f32x4 cnl = rol1_4(acc[ai][1][0][0]), cnh = rol1_4(acc[ai][1][0][1]);
#pragma unroll
            for (int m = 0; m < 4; ++m) {
                const f32x4 gl = acc[ai][1][m][0], gh = acc[ai][1][m][1];
                const f32x4 rl_ = ror1_4(gl), rh_ = ror1_4(gh);
                f32x4 pl = rl_, ph = rh_, nl = cnl, nh = cnh, enl, enh;
                if (m < 3) { enl = rol1_4(acc[ai][1][m < 3 ? m + 1 : 3][0]); enh = rol1_4(acc[ai][1][m < 3 ? m + 1 : 3][1]); } else { enl = xnl; enh = xnh; }
                if (fr == 0) { pl = rpl; ph = rph; }
                if (fr == 15) { nl = enl; nh = enh; }
                rpl = rl_; rph = rh_; cnl = enl; cnh = enh;
                f32x4 ol = bl + pl * w0l + gl * w1l + nl * w2l, oh = bh + ph * w0h + gh * w1h + nh * w2h;
                const f32x4 al = acc[ai][0][m][0], ah = acc[ai][0][m][1];
#pragma unroll
                for (int i = 0; i < 1; ++i) { ol = gelu_tanh4(ol) * al; oh = gelu_tanh4(oh) * ah; }
                const int rl = ai * 128 + wr * 64 + m * 16 + fr, t = st + rl;
                if ((rl >= 1 || t == 0) && (rl <= 254 || t == SEQ - 1))
                    *(u32x4*)(HH + ((size_t)(b * SEQ + t)) * DFF + F) = pk8(ol, oh);
                __builtin_amdgcn_sched_barrier(0);
            }
        }
    }
};

struct RowSq {
    unsigned* xbuf; unsigned* cnt;
    __device__ __forceinline__ void run(const f32x4 (&v)[2][2][4][2], const Unit& u, int wr, int wc, int fr, int fq, LAS unsigned char* lds, int wid, int lane) const {
        LAS float* P = (LAS float*)lds; LAS float* S = (LAS float*)(lds + 4096);
#pragma unroll
        for (int ai = 0; ai < 2; ++ai)
#pragma unroll
            for (int m = 0; m < 4; ++m) {
                float s = 0.f;
#pragma unroll
                for (int bj = 0; bj < 2; ++bj)
#pragma unroll
                    for (int n = 0; n < 2; ++n) { const f32x4 x = v[ai][bj][m][n]; s += (x[0] * x[0] + x[1] * x[1]) + (x[2] * x[2] + x[3] * x[3]); }
                s += __shfl_xor(s, 16); s += __shfl_xor(s, 32);
                if (fq == 0) P[(ai * 128 + wr * 64 + m * 16 + fr) * 4 + wc] = s;
            }
        asm volatile("s_waitcnt lgkmcnt(0)" ::: "memory"); __builtin_amdgcn_s_barrier(); asm volatile("" ::: "memory");
        const int row = wid * 32 + (lane & 31);
        if (lane < 32) { const float t = (P[row * 4 + 0] + P[row * 4 + 1]) + (P[row * 4 + 2] + P[row * 4 + 3]);
            __hip_atomic_store(xbuf + ((size_t)(u.pm * 256 + row) * 4 + u.pn), __float_as_uint(t), __ATOMIC_RELAXED, __HIP_MEMORY_SCOPE_AGENT); }
        asm volatile("s_waitcnt vmcnt(0)" ::: "memory");
        if (lane == 0) __hip_atomic_fetch_add(cnt + 64 * u.pm, 1u, __ATOMIC_RELAXED, __HIP_MEMORY_SCOPE_AGENT);
        if (wid == 0) {
            unsigned sp = 0;
            while ((unsigned)__builtin_amdgcn_readfirstlane(__hip_atomic_load(cnt + 64 * u.pm, __ATOMIC_RELAXED, __HIP_MEMORY_SCOPE_AGENT)) < 32u) { __builtin_amdgcn_s_sleep(2); if (++sp > (1u << 22)) break; }
        }
        asm volatile("s_waitcnt vmcnt(0) lgkmcnt(0)" ::: "memory"); __builtin_amdgcn_s_barrier(); asm volatile("" ::: "memory");
        if (lane < 32) { unsigned* slot = xbuf + (size_t)(u.pm * 256 + row) * 4; float t = 0.f;
#pragma unroll
            for (int q = 0; q < 4; ++q) t += __uint_as_float(__hip_atomic_load(slot + q, __ATOMIC_RELAXED, __HIP_MEMORY_SCOPE_AGENT));
            S[row] = 1.0f / sqrtf(t * (1.0f / 1024.0f) + EPS); }
        asm volatile("s_waitcnt lgkmcnt(0)" ::: "memory"); __builtin_amdgcn_s_barrier(); asm volatile("" ::: "memory");
    }
};
struct EpiOutNorm {
    static constexpr bool AFTER_DRAIN = true;
    const float* x; bf16_t* X1B; bf16_t* XN; const float* MOD; const float* w; RowSq st;
    __device__ __forceinline__ void fused(f32x4 (&acc)[2][2][4][2], const Unit& u, int wr, int wc, int fr, int fq, LAS unsigned char* lds, int wid, int lane) const {
        f32x4 xa[2][2][2], xb[2][2][2];
#define LOADB(dst, am) do { const int ai_ = (am) >> 1, m0_ = ((am) & 1) * 2; _Pragma("unroll") for (int mm = 0; mm < 2; ++mm) { const int r_ = u.pm * 256 + ai_ * 128 + wr * 64 + (m0_ + mm) * 16 + fr; \
            _Pragma("unroll") for (int bj = 0; bj < 2; ++bj) { const float* bp = x + (size_t)r_ * 1024 + u.pn * 256 + bj * 128 + wc * 32 + 8 * fq; dst[mm][bj][0] = *(const f32x4*)bp; dst[mm][bj][1] = *(const f32x4*)(bp + 4); } } } while (0)
#define USEB(src, am) do { const int ai = (am) >> 1, m0_ = ((am) & 1) * 2; _Pragma("unroll") for (int mm = 0; mm < 2; ++mm) { const int m = m0_ + mm; const int r = u.pm * 256 + ai * 128 + wr * 64 + m * 16 + fr, b = r >> 13; \
            _Pragma("unroll") for (int bj = 0; bj < 2; ++bj) { const int c = u.pn * 256 + bj * 128 + wc * 32 + 8 * fq; \
                const float* gp = MOD + b * 6144 + 2048 + c; const f32x4 g0 = *(const f32x4*)gp, g1 = *(const f32x4*)(gp + 4); \
                const f32x4 y0 = src[mm][bj][0] + g0 * acc[ai][bj][m][0], y1 = src[mm][bj][1] + g1 * acc[ai][bj][m][1]; \
                acc[ai][bj][m][0] = y0; acc[ai][bj][m][1] = y1; \
                *(u32x4*)(X1B + (size_t)r * 1024 + c) = pk8(y0, y1); } } asm volatile("" ::: "memory"); } while (0)
        LOADB(xa, 0); LOADB(xb, 1); USEB(xa, 0); LOADB(xa, 2); USEB(xb, 1); LOADB(xb, 3); USEB(xa, 2); USEB(xb, 3);
#undef LOADB
#undef USEB
        __builtin_amdgcn_sched_barrier(0);
        st.run(acc, u, wr, wc, fr, fq, lds, wid, lane);
        const LAS float* S = (const LAS float*)(lds + 4096);
#pragma unroll
        for (int ai = 0; ai < 2; ++ai)
#pragma unroll
            for (int m = 0; m < 4; ++m) { const int rl = ai * 128 + wr * 64 + m * 16 + fr, r = u.pm * 256 + rl, b = r >> 13; const float rs = S[rl];
#pragma unroll
                for (int bj = 0; bj < 2; ++bj) { const int c = u.pn * 256 + bj * 128 + wc * 32 + 8 * fq;
                    const float* mp = MOD + b * 6144 + c;
                    const f32x4 sh0 = *(const f32x4*)(mp + 3072), sh1 = *(const f32x4*)(mp + 3076), sc0 = *(const f32x4*)(mp + 4096), sc1 = *(const f32x4*)(mp + 4100);
                    const f32x4 w0 = *(const f32x4*)(w + c), w1 = *(const f32x4*)(w + c + 4);
                    const f32x4 y0 = acc[ai][bj][m][0] * rs * w0 * (sc0 + 1.0f) + sh0, y1 = acc[ai][bj][m][1] * rs * w1 * (sc1 + 1.0f) + sh1;
                    *(u32x4*)(XN + (size_t)r * 1024 + c) = pk8(y0, y1); }
                asm volatile("" ::: "memory"); __builtin_amdgcn_sched_barrier(0); }
    }
};
struct EpiDownNorm {
    static constexpr bool AFTER_DRAIN = true;
    const bf16_t* X1B; float* out; const float* MOD; const float* w; RowSq st;
    __device__ __forceinline__ void fused(f32x4 (&acc)[2][2][4][2], const Unit& u, int wr, int wc, int fr, int fq, LAS unsigned char* lds, int wid, int lane) const {
        u32x4 xs[2][4][2];
#pragma unroll
        for (int ai = 0; ai < 2; ++ai)
#pragma unroll
            for (int m = 0; m < 4; ++m) { const int r = u.pm * 256 + ai * 128 + wr * 64 + m * 16 + fr;
#pragma unroll
                for (int bj = 0; bj < 2; ++bj) xs[ai][m][bj] = *(const u32x4*)(X1B + (size_t)r * 1024 + u.pn * 256 + bj * 128 + wc * 32 + 8 * fq); }
#pragma unroll
        for (int ai = 0; ai < 2; ++ai) {
#pragma unroll
            for (int m = 0; m < 4; ++m) { const int r = u.pm * 256 + ai * 128 + wr * 64 + m * 16 + fr, b = r >> 13;
#pragma unroll
                for (int bj = 0; bj < 2; ++bj) { const int c = u.pn * 256 + bj * 128 + wc * 32 + 8 * fq;
                    const float* gp = MOD + b * 6144 + 5120 + c; const f32x4 g0 = *(const f32x4*)gp, g1 = *(const f32x4*)(gp + 4);
                    f32x4 x0, x1; unpk8(xs[ai][m][bj], x0, x1);
                    acc[ai][bj][m][0] = x0 + g0 * acc[ai][bj][m][0]; acc[ai][bj][m][1] = x1 + g1 * acc[ai][bj][m][1]; }
                asm volatile("" : "+v"(acc[ai][0][m][0]), "+v"(acc[ai][0][m][1]), "+v"(acc[ai][1][m][0]), "+v"(acc[ai][1][m][1]));
            } }
        asm volatile("" ::: "memory"); __builtin_amdgcn_sched_barrier(0);
        st.run(acc, u, wr, wc, fr, fq, lds, wid, lane);
        const LAS float* S = (const LAS float*)(lds + 4096);
#pragma unroll
        for (int ai = 0; ai < 2; ++ai)
#pragma unroll
            for (int m = 0; m < 4; ++m) { const int rl = ai * 128 + wr * 64 + m * 16 + fr, r = u.pm * 256 + rl; const float rs = S[rl];
#pragma unroll
                for (int bj = 0; bj < 2; ++bj) { const int c = u.pn * 256 + bj * 128 + wc * 32 + 8 * fq;
                    const f32x4 w0 = *(const f32x4*)(w + c), w1 = *(const f32x4*)(w + c + 4);
                    float* op = out + (size_t)r * 1024 + c; *(f32x4*)op = acc[ai][bj][m][0] * rs * w0; *(f32x4*)(op + 4) = acc[ai][bj][m][1] * rs * w1; }
                asm volatile("" ::: "memory"); __builtin_amdgcn_sched_barrier(0); }
    }
};

template <bool UPMAP = false>
__device__ __forceinline__ void transpose_item(const float* W, int K, int N, bf16_t* WT, LAS float* scr, int item, int lane) {
    const int nblk = N / 32, kb = item / nblk, nb = item % nblk, k0 = 64 * kb, n0 = 32 * nb;
    const int d0 = !UPMAP ? n0 : (n0 < DFF ? 256 * (n0 >> 7) + (n0 & 127) : 256 * ((n0 - DFF) >> 7) + 128 + ((n0 - DFF) & 127));
    { f32x4 v[8]; const int kr = lane >> 3, c4 = (lane & 7) * 4;
#pragma unroll
      for (int i = 0; i < 8; ++i) v[i] = *(const f32x4*)(W + (size_t)(k0 + i * 8 + kr) * N + n0 + c4);
#pragma unroll
      for (int i = 0; i < 8; ++i) { LAS float* d = scr + (i * 8 + kr) * 33 + c4; d[0] = v[i][0]; d[1] = v[i][1]; d[2] = v[i][2]; d[3] = v[i][3]; } }
    asm volatile("s_waitcnt lgkmcnt(0)" ::: "memory");
    const int c = lane & 7;
#pragma unroll
    for (int j = 0; j < 4; ++j) { const int n = (lane >> 3) + 8 * j; const LAS float* s = scr + (8 * c) * 33 + n;
        u32x4 o; o.x = cvt_pk_bf16(s[0 * 33], s[1 * 33]); o.y = cvt_pk_bf16(s[2 * 33], s[3 * 33]); o.z = cvt_pk_bf16(s[4 * 33], s[5 * 33]); o.w = cvt_pk_bf16(s[6 * 33], s[7 * 33]);
        *(u32x4*)(WT + (size_t)(d0 + n) * K + k0 + 8 * c) = o; }
    asm volatile("s_waitcnt lgkmcnt(0)" ::: "memory");
}

__device__ __forceinline__ void norm_rows2_bf16(const float* xa, const float* xb, const float* w, const LAS float* sha, const LAS float* sca, const LAS float* shb, const LAS float* scb, bf16_t* oa, bf16_t* ob, int lane) {
    const f32x4* pa = (const f32x4*)xa + lane; const f32x4* pb = (const f32x4*)xb + lane;
    f32x4 va[4], vb[4]; float s0 = 0.f, s1 = 0.f;
#pragma unroll
    for (int j = 0; j < 4; ++j) { va[j] = pa[64 * j]; vb[j] = pb[64 * j]; }
#pragma unroll
    for (int j = 0; j < 4; ++j) { s0 += (va[j][0] * va[j][0] + va[j][1] * va[j][1]) + (va[j][2] * va[j][2] + va[j][3] * va[j][3]); s1 += (vb[j][0] * vb[j][0] + vb[j][1] * vb[j][1]) + (vb[j][2] * vb[j][2] + vb[j][3] * vb[j][3]); }
    const float ra = 1.0f / sqrtf(wave_sum(s0) * (1.0f / 1024.0f) + EPS), rb = 1.0f / sqrtf(wave_sum(s1) * (1.0f / 1024.0f) + EPS);
#pragma unroll
    for (int j = 0; j < 4; ++j) {
        const int c = 4 * (lane + 64 * j);
        const f32x4 ww = *(const f32x4*)(w + c);
        const f32x4 ya = va[j] * ra * ww * (*(const LAS f32x4*)(sca + c) + 1.0f) + *(const LAS f32x4*)(sha + c);
        const f32x4 yb = vb[j] * rb * ww * (*(const LAS f32x4*)(scb + c) + 1.0f) + *(const LAS f32x4*)(shb + c);
        u32x2 o; o.x = cvt_pk_bf16(ya[0], ya[1]); o.y = cvt_pk_bf16(ya[2], ya[3]); *(u32x2*)(oa + c) = o;
        o.x = cvt_pk_bf16(yb[0], yb[1]); o.y = cvt_pk_bf16(yb[2], yb[3]); *(u32x2*)(ob + c) = o;
    }
}

constexpr int LDS_BYTES = STAGE_BYTES + 12288;
#define PHASE_IDS int tid_p = threadIdx.x; asm volatile("" : "+v"(tid_p)); const int tid = tid_p, lane = tid & 63, wave = __builtin_amdgcn_readfirstlane(tid >> 6), gw = bx * 8 + wave; (void)lane; (void)gw; (void)tid;

__global__ void __launch_bounds__(512, 2) fwd_kernel(Params p) {
    extern __shared__ __attribute__((aligned(16))) unsigned char lds_raw[];
    LAS unsigned char* lds = (LAS unsigned char*)lds_raw;
    cg::grid_group grid = cg::this_grid();
    { volatile LAS unsigned* st0 = (volatile LAS unsigned*)(lds + STAGE_BYTES); if (threadIdx.x < 4) st0[threadIdx.x] = 0u; }
    __syncthreads();
    const XcdBarrier xbar = xcd_barrier_post((unsigned*)(p.ws + WS_BAR), (volatile LAS unsigned*)(lds + STAGE_BYTES));
    if (p.ws == nullptr) grid.sync();
#define GRID_BAR() xcd_barrier(xbar)
    const int G = gridDim.x, bx = blockIdx.x, NGW = G * 8;
    unsigned char* ws = p.ws;
    const float* x = p.in[0]; const float* cvec = p.in[1]; const float* ctx = p.in[2]; const float* cctx = p.in[3];
    const float* w_mod = p.in[4]; const float* b_mod = p.in[5];
    bf16_t* WIN = (bf16_t*)(ws + WS_WIN); bf16_t* WGLU = (bf16_t*)(ws + WS_WGLU); bf16_t* WOUT = (bf16_t*)(ws + WS_WOUT);
    bf16_t* S5E = (bf16_t*)(ws + WS_S5E); bf16_t* S5WY = (bf16_t*)(ws + WS_S5WY);
    float* KT = (float*)(ws + WS_KT); unsigned* XCH = (unsigned*)(ws + WS_XCH); unsigned* CNT = (unsigned*)(ws + WS_CNT);
    float* MODP = (float*)(ws + WS_MODP); float* MOD = (float*)(ws + WS_MOD); f32x2* ROPE = (f32x2*)(ws + WS_ROPE); f32x2* L16 = (f32x2*)(ws + WS_L16);
    bf16_t* WUP = (bf16_t*)(ws + WS_WUP); bf16_t* WDOWN = (bf16_t*)(ws + WS_WDOWN);
    bf16_t* XN = (bf16_t*)(ws + WS_XN); bf16_t* KVT = (bf16_t*)(ws + WS_KVT); bf16_t* YG = (bf16_t*)(ws + WS_XN);
    bf16_t* US = (bf16_t*)(ws + WS_US); bf16_t* QB = (bf16_t*)(ws + WS_QB); bf16_t* KB = (bf16_t*)(ws + WS_KB); bf16_t* GB = (bf16_t*)(ws + WS_GB);
    bf16_t* KW = (bf16_t*)(ws + WS_KW); bf16_t* X1B = (bf16_t*)(ws + WS_KW);
    bf16_t* BTU = (bf16_t*)(ws + WS_BTU);
    bf16_t* SST = (bf16_t*)(ws + WS_SST); bf16_t* MIX = (bf16_t*)(ws + WS_SST); bf16_t* HAG = (bf16_t*)(ws + WS_HAG);
    bf16_t* A2U = (bf16_t*)p.out;
    const float* ldf = p.in[21]; const float* ldb = p.in[22];

    for (int rep_ = 0; rep_ < (((REPM >> 0) & 1) ? 2 : 1); ++rep_) { if constexpr ((PM >> 0) & 1) {
        PHASE_IDS
        LAS float* scr = (LAS float*)(lds + wave * 16384);
        constexpr int I_IN = 16 * 80, I_GLU = 8 * 16, I_OUT = 16 * 32, I_T = I_IN + I_GLU + I_OUT, I_ALL = I_T + 768;
        for (int it = gw; it < I_ALL; it += NGW) {
            int r = it;
            if (r < I_IN) { transpose_item(p.in[7], 1024, INC, WIN, scr, r, lane); continue; } r -= I_IN;
            if (r < I_GLU) { transpose_item(p.in[19], 512, 512, WGLU, scr, r, lane); continue; } r -= I_GLU;
            if (r < I_OUT) { transpose_item(p.in[23], 1024, 1024, WOUT, scr, r, lane); continue; } r -= I_OUT;
            const int cgp = r >> 3, kc = r & 7, col = cgp * 64 + lane;
            float sv[3][2];
#pragma unroll
            for (int hh = 0; hh < 2; ++hh) { const int k = kc * 128 + hh * 64 + lane; sv[0][hh] = silu_(cvec[k]); sv[1][hh] = silu_(cvec[1024 + k]); sv[2][hh] = silu_(cctx[k]); }
            float a0 = 0.f, a1 = 0.f, a2 = 0.f;
            const float* wp = w_mod + (size_t)(kc * 128) * 6144 + col;
#pragma unroll
            for (int hh = 0; hh < 2; ++hh) {
                float wv[64];
#pragma unroll
                for (int kk = 0; kk < 64; ++kk) wv[kk] = wp[(size_t)(hh * 64 + kk) * 6144];
#pragma unroll
                for (int kk = 0; kk < 64; ++kk) { a0 += __shfl(sv[0][hh], kk) * wv[kk]; a1 += __shfl(sv[1][hh], kk) * wv[kk]; a2 += __shfl(sv[2][hh], kk) * wv[kk]; }
            }
            MODP[(kc * 3 + 0) * 6144 + col] = a0; MODP[(kc * 3 + 1) * 6144 + col] = a1; MODP[(kc * 3 + 2) * 6144 + col] = a2;
        }
        for (int idx = bx * 512 + tid; idx < 4096; idx += G * 512) { const int pos = idx >> 5, j = idx & 31; const float invf = exp2f(-(float)j * (13.287712379549449f / 32.0f)); float s, c; sincos_red((float)pos * invf, s, c); ROPE[idx] = (f32x2){c, s}; }
        __syncthreads();
        for (int vj = bx; vj < 256; vj += G) {
            const int g = vj >> 3, sub = vj & 7;
            LAS f32x2* Lp = (LAS f32x2*)lds;
            LAS f32x2* bbar = (LAS f32x2*)(lds + 17408);
            LAS f32x2* Cc = (LAS f32x2*)(lds + 17408 + 16384);
            LAS f32x2* coef = (LAS f32x2*)(lds + 17408 + 16384 + 8192);
            __syncthreads();
            if (tid < 128) {
                const int d = tid >> 6, n = tid & 63;
                const float lr = p.in[d ? 11 : 8][g * 64 + n], li = p.in[d ? 12 : 9][g * 64 + n], step = expf(p.in[d ? 13 : 10][g]);
                const float mag = expf(lr * step); float sn, cs; sincos_red(li * step, sn, cs);
                const float br = mag * cs, bi = mag * sn;
                float pr = 1.f, pi = 0.f;
#pragma unroll 1
                for (int tau = 0; tau <= 16; ++tau) { Lp[(d * 17 + tau) * 64 + n] = (f32x2){pr, pi}; const float nr = pr * br - pi * bi, ni = pr * bi + pi * br; pr = nr; pi = ni; }
                const float nr_ = br - 1.0f, ni_ = bi, den = lr * lr + li * li;
                coef[d * 64 + n] = (f32x2){(nr_ * lr + ni_ * li) / den, (ni_ * lr - nr_ * li) / den};
            }
            __syncthreads();
            if (sub == 0 && tid < 128) L16[g * 128 + tid] = Lp[((tid >> 6) * 17 + 16) * 64 + (tid & 63)];
            for (int idx = tid; idx < 2048; idx += 512) { const int d = idx >> 10, n = (idx >> 4) & 63, pp = idx & 15;
                const float bre = p.in[14][(g * 64 + n) * 16 + pp], bim = p.in[15][(g * 64 + n) * 16 + pp]; const f32x2 cf = coef[d * 64 + n];
                bbar[idx] = (f32x2){cf[0] * bre - cf[1] * bim, cf[0] * bim + cf[1] * bre}; }
            for (int idx = tid; idx < 1024; idx += 512) Cc[idx] = (f32x2){p.in[16][g * 1024 + idx], p.in[17][g * 1024 + idx]};
            __syncthreads();
            for (int idx = tid; idx < 1024; idx += 512) { const int d = idx >> 9, tau = 2 * sub + ((idx >> 8) & 1), pp = (idx >> 4) & 15, pq = idx & 15;
                float a = 0.f;
#pragma unroll 4
                for (int n = 0; n < 64; ++n) { const f32x2 cz = Cc[pp * 64 + n], lz = Lp[(d * 17 + tau) * 64 + n], bz = bbar[(d * 64 + n) * 16 + pq];
                    const float zr = cz[0] * lz[0] - cz[1] * lz[1], zi = cz[0] * lz[1] + cz[1] * lz[0]; a += zr * bz[0] - zi * bz[1]; }
                KT[((g * 2 + d) * 16 + tau) * 256 + pp * 16 + pq] = a; }
            for (int idx = tid; idx < 1024; idx += 512) { const int row = sub * 32 + (idx >> 5), c8 = (idx & 31) * 8, d = row >> 7, ri = (row >> 6) & 1, n = row & 63, sx = c8 >> 4, q0 = c8 & 15;
                const f32x2 lz = Lp[(d * 17 + (d ? sx : 15 - sx)) * 64 + n]; float o[8];
#pragma unroll
                for (int i = 0; i < 8; ++i) { const f32x2 bz = bbar[(d * 64 + n) * 16 + q0 + i]; o[i] = ri ? (lz[0] * bz[1] + lz[1] * bz[0]) : (lz[0] * bz[0] - lz[1] * bz[1]); }
                u32x4 w; w.x = cvt_pk_bf16(o[0], o[1]); w.y = cvt_pk_bf16(o[2], o[3]); w.z = cvt_pk_bf16(o[4], o[5]); w.w = cvt_pk_bf16(o[6], o[7]);
                *(u32x4*)(S5E + ((size_t)(g * 256 + row) * 256 + c8)) = w; }
            for (int idx = tid; idx < 1024; idx += 512) { const int rowl = idx >> 5, t = 2 * sub + (rowl >> 4), pp = rowl & 15, row = t * 16 + pp, kk = (idx & 31) * 8;
                const int d = kk >> 7, ri = (kk >> 6) & 1, n0 = kk & 63, pw = d ? (16 - t) : (t + 1); float o[8];
#pragma unroll
                for (int i = 0; i < 8; ++i) { const f32x2 cz = Cc[pp * 64 + n0 + i], lz = Lp[(d * 17 + pw) * 64 + n0 + i];
                    o[i] = ri ? -(cz[0] * lz[1] + cz[1] * lz[0]) : (cz[0] * lz[0] - cz[1] * lz[1]); }
                u32x4 w; w.x = cvt_pk_bf16(o[0], o[1]); w.y = cvt_pk_bf16(o[2], o[3]); w.z = cvt_pk_bf16(o[4], o[5]); w.w = cvt_pk_bf16(o[6], o[7]);
                *(u32x4*)(S5WY + ((size_t)(g * 256 + row) * 512 + 256 + kk)) = w; }
            __syncthreads();
        }
    }
    GRID_BAR(); }

    for (int rep_ = 0; rep_ < (((REPM >> 1) & 1) ? 2 : 1); ++rep_) { if constexpr ((PM >> 1) & 1) {
        PHASE_IDS
        LAS float* ms = (LAS float*)lds;
        { float pv[12][8];
#pragma unroll
          for (int k = 0; k < 12; ++k) { const int idx = tid + 512 * k, r = idx >> 11, j = idx & 2047;
#pragma unroll
              for (int q = 0; q < 8; ++q) pv[k][q] = MODP[(q * 3 + r) * 6144 + j]; }
#pragma unroll
          for (int k = 0; k < 12; ++k) { const int idx = tid + 512 * k, j = idx & 2047;
              ms[idx] = b_mod[j] + ((pv[k][0] + pv[k][1]) + (pv[k][2] + pv[k][3])) + ((pv[k][4] + pv[k][5]) + (pv[k][6] + pv[k][7])); } }
        for (int idx = bx * 512 + tid; idx < 3 * 6144; idx += G * 512) { const int r = idx / 6144, j = idx % 6144; float a = b_mod[j];
#pragma unroll
            for (int q = 0; q < 8; ++q) a += MODP[(q * 3 + r) * 6144 + j];
            MOD[idx] = a; }
        __syncthreads();
        for (int rp = gw; rp < MALL / 2; rp += NGW) {
            const int ra = rp, rb = rp + MALL / 2;
            const int ca = ra < SEQ ? 0 : (ra < MLAT ? 1 : 2), cb2 = rb < SEQ ? 0 : (rb < MLAT ? 1 : 2);
            const float* sa = ra < MLAT ? x + (size_t)ra * 1024 : ctx + (size_t)(ra - MLAT) * 1024;
            const float* sb = rb < MLAT ? x + (size_t)rb * 1024 : ctx + (size_t)(rb - MLAT) * 1024;
            norm_rows2_bf16(sa, sb, p.in[6], ms + ca * 2048, ms + ca * 2048 + 1024, ms + cb2 * 2048, ms + cb2 * 2048 + 1024, XN + (size_t)ra * 1024, XN + (size_t)rb * 1024, lane);
        }
        __syncthreads();
    }
    GRID_BAR(); }

    for (int rep_ = 0; rep_ < (((REPM >> 2) & 1) ? 2 : 1); ++rep_) { if constexpr ((PM >> 2) & 1) {
        PHASE_IDS
        SchedIn S{66, 6, 396, G, bx, 0, 2, (const char*)XN, (const char*)WIN, 0, 2 * G - 396, 2};
        EpiIn E{US, QB, KB, GB, KW, BTU, A2U, ROPE, ldf, ldb};
        gemm_phase(lds, 1024, 1024, 1024, S, E);
    }
    GRID_BAR(); }

    for (int rep_ = 0; rep_ < (((REPM >> 3) & 1) ? 2 : 1); ++rep_) { if constexpr ((PM >> 3) & 1) {
        PHASE_IDS
        const int qdone = 2 * G - 396, nA = (128 - qdone) + 128;
        { SchedIn S{64, 2, 0, nA, bx < nA ? bx : -1, 0, 0, (const char*)XN, (const char*)WIN, qdone, 128, 2};
          EpiIn E{US, QB, KB, GB, KW, BTU, A2U, ROPE, ldf, ldb};
          gemm_phase(lds, 1024, 1024, 1024, S, E); }
        { SchedIn S{64, 2, 0, nA, (bx < nA && bx >= 128 - qdone) ? bx - (128 - qdone) : -1, 0, 0, (const char*)XN, (const char*)WIN, 0, 128, 8};
          EpiIn E{US, QB, KB, GB, KW, BTU, A2U, ROPE, ldf, ldb};
          gemm_phase(lds, 1024, 1024, 1024, S, E); }
        { SchedP3 S{G - nA, bx >= nA ? bx - nA : -1, 256, 680, (const char*)QB, (const char*)KB, (const char*)BTU, (const char*)KW, (const char*)US, (const char*)S5E};
          EpiP3 E{EpiS{A2U, ldf, ldb}, EpiKV{KVT}, EpiE{SST}};
          gemm_phase(lds, 512, 256, 256, S, E); }
    }
    GRID_BAR(); }

    for (int rep_ = 0; rep_ < (((REPM >> 4) & 1) ? 2 : 1); ++rep_) { if constexpr ((PM >> 4) & 1) {
        PHASE_IDS
        const int hG = G >> 1;
        if (bx >= hG) for (int idx = (bx - hG) * 512 + tid; idx < 32 * 256 * 32; idx += (G - hG) * 512) { const int g = idx >> 13, row = (idx >> 5) & 255, k8 = (idx & 31) * 8, t = row >> 4, pp = row & 15, sx = k8 >> 4, q0 = k8 & 15;
            const float* kt = KT + (size_t)g * 2 * 16 * 256 + pp * 16 + q0; f32x4 lo, hi;
            if (sx < t) { const float* q = kt + (t - sx) * 256; lo = *(const f32x4*)q; hi = *(const f32x4*)(q + 4); }
            else if (sx > t) { const float* q = kt + (16 + (sx - t)) * 256; lo = *(const f32x4*)q; hi = *(const f32x4*)(q + 4); }
            else { const float* q = kt; const float* q2 = kt + 16 * 256; lo = *(const f32x4*)q + *(const f32x4*)q2; hi = *(const f32x4*)(q + 4) + *(const f32x4*)(q2 + 4); }
            *(u32x4*)(S5WY + ((size_t)(g * 256 + row) * 512 + k8)) = pk8(lo, hi); }
        if (bx < hG) for (int vj = bx; vj < 128; vj += hG) {
            const int g = vj >> 2, b = (vj >> 1) & 1, dir = vj & 1, n = lane;
            const f32x2 lam = L16[(g * 2 + dir) * 64 + n];
            float ar = 1.f, ai_ = 0.f;
#pragma unroll 1
            for (int i = 0; i < 66; ++i) { const float nr = ar * lam[0] - ai_ * lam[1], ni = ar * lam[1] + ai_ * lam[0]; ar = nr; ai_ = ni; }
            LAS f32x2* ex = (LAS f32x2*)lds;
            const bf16_t* sbase = SST + (size_t)g * 1280 * 256 + dir * 128 + n;
            const int q0 = wave * 66;
            unsigned sv[66];
#pragma unroll
            for (int j = 0; j < 66; ++j) { const int q = q0 + j; const int row = (q < 16) ? (1024 + b * 16 + (dir ? 15 - q : q)) : (b * 512 + (dir ? 511 - (q - 16) : (q - 16)));
                sv[j] = (unsigned)sbase[(size_t)row * 256] | ((unsigned)sbase[(size_t)row * 256 + 64] << 16); }
            float hr = 0.f, hi_ = 0.f;
#pragma unroll
            for (int j = 0; j < 66; ++j) { const float sr = __uint_as_float(sv[j] << 16), si = __uint_as_float(sv[j] & 0xffff0000u);
                const float nr = hr * lam[0] - hi_ * lam[1] + sr, ni = hr * lam[1] + hi_ * lam[0] + si; hr = nr; hi_ = ni; }
            __syncthreads();
            ex[wave * 64 + n] = (f32x2){hr, hi_};
            __syncthreads();
            hr = 0.f; hi_ = 0.f;
            for (int w2 = 0; w2 < wave; ++w2) { const f32x2 e = ex[w2 * 64 + n]; const float nr = hr * ar - hi_ * ai_ + e[0], ni = hr * ai_ + hi_ * ar + e[1]; hr = nr; hi_ = ni; }
            bf16_t* ubase = US + (size_t)g * 1280 * 512 + 256 + dir * 128 + n;
#pragma unroll
            for (int j = 0; j < 66; ++j) { const int q = q0 + j; const int row = (q < 16) ? (1024 + b * 16 + (dir ? 15 - q : q)) : (b * 512 + (dir ? 511 - (q - 16) : (q - 16)));
                if (q >= 16) { ubase[(size_t)row * 512] = f2bf(hr); ubase[(size_t)row * 512 + 64] = f2bf(hi_); }
                const float sr = __uint_as_float(sv[j] << 16), si = __uint_as_float(sv[j] & 0xffff0000u);
                const float nr = hr * lam[0] - hi_ * lam[1] + sr, ni = hr * lam[1] + hi_ * lam[0] + si; hr = nr; hi_ = ni; }
            __syncthreads();
        }
        for (int vj = bx; vj < 256; vj += G) {
            const int bh = vj >> 5, slice = vj & 31, h = bh & 3, e = slice * 4 + (tid >> 7), col = 2 * (tid & 127), dir = col >> 7;
            const float dec = expf((dir ? ldb[h] : ldf[h]) * 256.0f);
            const bf16_t* kbase = KVT + ((size_t)(bh * 33) * 128 + e) * 256 + col;
            bf16_t* obase = BTU + ((size_t)(bh * 33) * 128 + e) * 512 + 256 + col;
            unsigned kvw[33];
#pragma unroll
            for (int j = 0; j < 33; ++j) kvw[j] = *(const unsigned*)(kbase + (size_t)j * 128 * 256);
            f32x2 R; R[0] = __uint_as_float(kvw[32] << 16); R[1] = __uint_as_float(kvw[32] & 0xffff0000u);
            if (dir == 0) {
#pragma unroll
                for (int cc = 0; cc < 32; ++cc) { *(unsigned*)(obase + (size_t)cc * 128 * 512) = cvt_pk_bf16(R[0], R[1]);
                    R[0] = R[0] * dec + __uint_as_float(kvw[cc] << 16); R[1] = R[1] * dec + __uint_as_float(kvw[cc] & 0xffff0000u); }
            } else {
#pragma unroll
                for (int cc = 31; cc >= 0; --cc) { *(unsigned*)(obase + (size_t)cc * 128 * 512) = cvt_pk_bf16(R[0], R[1]);
                    R[0] = R[0] * dec + __uint_as_float(kvw[cc] << 16); R[1] = R[1] * dec + __uint_as_float(kvw[cc] & 0xffff0000u); }
            }
        }
        { SchedP3 S{G, bx, 0, 256, (const char*)A2U  , (const char*)KB, (const char*)BTU, (const char*)KW, (const char*)US, (const char*)S5E};
          EpiP3 E{EpiS{A2U, ldf, ldb}, EpiKV{KVT}, EpiE{SST}};
          gemm_phase(lds, 512, 256, 256, S, E); }
    }
    GRID_BAR(); }

    for (int rep_ = 0; rep_ < (((REPM >> 5) & 1) ? 2 : 1); ++rep_) { if constexpr ((PM >> 5) & 1) {
        PHASE_IDS
        const int hG = G >> 1;
        { SchedY S{hG, bx < hG ? bx : -1, (const char*)US, (const char*)S5WY}; EpiY E{US, YG, p.in[18]}; gemm_phase(lds, 512, 512, 512, S, E); }
        { SchedO S{G - hG, bx >= hG ? bx - hG : -1, 0, 128, (const char*)A2U, (const char*)BTU}; EpiOLn E{GB, MIX, (LAS f32x2*)(lds + STAGE_BYTES + 64)}; gemm_phase(lds, 512, 512, 512, S, E); }
    }
    GRID_BAR(); }

    for (int rep_ = 0; rep_ < (((REPM >> 6) & 1) ? 2 : 1); ++rep_) { if constexpr ((PM >> 6) & 1) {
        PHASE_IDS
        const int hG = G >> 1;
        { SchedStatic S; S.init(MLAT, 512, 512, 512, YG, WGLU, hG, bx < hG ? bx : (1 << 28)); EpiGlu E{YG, MIX, p.in[20]}; gemm_phase(lds, 512, 512, 512, S, E); }
        { SchedO S{G - hG, bx >= hG ? bx - hG : -1, 128, 256, (const char*)A2U, (const char*)BTU}; EpiOLn E{GB, MIX, (LAS f32x2*)(lds + STAGE_BYTES + 64)}; gemm_phase(lds, 512, 512, 512, S, E); }
        { LAS float* scr = (LAS float*)(lds + wave * 16384); constexpr int I_UP = 16 * 176;
            for (int it = gw; it < I_UP; it += NGW) transpose_item<true>(p.in[25], 1024, DFF2, WUP, scr, it, lane); }
    }
    GRID_BAR(); }

    for (int rep_ = 0; rep_ < (((REPM >> 7) & 1) ? 2 : 1); ++rep_) { if constexpr ((PM >> 7) & 1) {
        PHASE_IDS
        SchedStatic S; S.init(MLAT, 1024, 1024, 1024, MIX, WOUT, G, bx);
        EpiOutNorm E{x, X1B, XN, MOD, p.in[24], RowSq{XCH, CNT}};
        gemm_phase(lds, 1024, 1024, 1024, S, E);
    }
    GRID_BAR(); }

    for (int rep_ = 0; rep_ < (((REPM >> 9) & 1) ? 2 : 1); ++rep_) { if constexpr ((PM >> 9) & 1) {
        PHASE_IDS
        SchedUp S{G, bx, (const char*)XN, (const char*)WUP};
        EpiUpConv E{HAG, p.in[26], p.in[27], (LAS float*)(lds + STAGE_BYTES + 64)};
        gemm_phase(lds, 1024, 1024, 1024, S, E);
        { constexpr int NU = 66 * 22, I_DN = 44 * 32; const int nfull = NU % G;
          LAS float* scr = (LAS float*)(lds + wave * 16384);
          if (nfull > 0) { if (bx >= nfull) for (int it = (bx - nfull) * 8 + wave; it < I_DN; it += (G - nfull) * 8) transpose_item(p.in[28], DFF, 1024, WDOWN, scr, it, lane); }
          else for (int it = gw; it < I_DN; it += NGW) transpose_item(p.in[28], DFF, 1024, WDOWN, scr, it, lane); }
    }
    GRID_BAR(); }

    for (int xs_ = 0; xs_ < NXSYNC; ++xs_) GRID_BAR();
    if constexpr ((PM >> 11) & 1) {
        PHASE_IDS
        SchedStatic S; S.init(MLAT, 1024, DFF, DFF, HAG, WDOWN, G, bx);
        EpiDownNorm E{X1B, p.out, MOD, p.in[29], RowSq{XCH + 65536, CNT + 4096}};
        gemm_phase(lds, DFF, DFF, DFF, S, E);
    }
}

extern "C" void kernel_launch(void* const* d_in, const int* in_sizes, int n_in, void* d_out, int out_size, void* d_ws, size_t ws_size, hipStream_t stream) {
    static int grid = 0;
    if (grid == 0) {
        int dev = 0, cus = 0, per_cu = 0;
        hipGetDevice(&dev);
        hipDeviceGetAttribute(&cus, hipDeviceAttributeMultiprocessorCount, dev);
        hipFuncSetAttribute((const void*)fwd_kernel, hipFuncAttributeMaxDynamicSharedMemorySize, LDS_BYTES);
        hipOccupancyMaxActiveBlocksPerMultiprocessor(&per_cu, (const void*)fwd_kernel, 512, LDS_BYTES);
        if (per_cu < 1) { fprintf(stderr, "kernel_launch: occupancy query says %d blocks per CU\n", per_cu); per_cu = 1; }
        grid = cus;
        (void)hipGetLastError();
    }
    if (hipMemsetAsync((char*)d_ws + WS_BAR, 0, CTL_BYTES, stream) != hipSuccess) { fprintf(stderr, "kernel_launch: memset of the barrier words failed\n"); return; }
    Params p{};
    for (int i = 0; i < 30; ++i) p.in[i] = (const float*)d_in[i];
    p.out = (float*)d_out; p.ws = (unsigned char*)d_ws;
    void* args[] = {&p};
    hipError_t e = hipLaunchCooperativeKernel((const void*)fwd_kernel, dim3(grid), dim3(512), args, LDS_BYTES, stream);
    if (e != hipSuccess) fprintf(stderr, "cooperative launch failed: %s (grid %d)\n", hipGetErrorString(e), grid);
}
```
